# Optimizing an MI355X kernel written in HIP

```python
import math
import jax, jax.numpy as jnp
from jax import lax
import numpy as np

D_MODEL = 1024
BATCH = 2
SEQ = 8192
DEPTH = 4

GRID_W = 64
CTX_LEN = 256
HEAD_DIM = 64
D_FF = 4 * D_MODEL
NORM_EPS = 1e-6
ROPE_BASE = 10000.0
NEG_INF = -1e30

GROUP_W = D_MODEL // 4
D_MIX = 4 * GROUP_W

NA_HEADS = GROUP_W // HEAD_DIM
WIN_H = 8
WIN_W = 16
NA_QBLK_W = 16
NA_KSPAN_W = 32

SWA_HEADS = GROUP_W // HEAD_DIM
SWA_KV_HEADS = 2
SWA_WINDOW = 128
SWA_BLOCK = 128

MLA_HEADS = 4
MLA_Q_LORA = 256
MLA_KV_LORA = 128
MLA_NOPE = 64
MLA_ROPE = 32
MLA_V = GROUP_W // MLA_HEADS
MLA_BLOCK = 128

SSD_INNER = GROUP_W
SSD_HEAD_DIM = 64
SSD_HEADS = SSD_INNER // SSD_HEAD_DIM
SSD_GROUPS = 2
SSD_STATE = 128
SSD_CONV = 5
SSD_CHUNK = 128
SSD_CONV_CH = SSD_INNER + 2 * SSD_GROUPS * SSD_STATE

NA_IN = 3 * NA_HEADS * HEAD_DIM
SWA_IN = (SWA_HEADS + 2 * SWA_KV_HEADS) * HEAD_DIM
MLA_IN = MLA_Q_LORA + MLA_KV_LORA + MLA_ROPE
SSD_IN = SSD_INNER + SSD_CONV_CH + 2 * SSD_HEADS
N_IN = NA_IN + SWA_IN + MLA_IN + SSD_IN
IN_SPLITS = (NA_IN, NA_IN + SWA_IN, NA_IN + SWA_IN + MLA_IN)

kernel_name = "hybrid_parallel_groups_dit_block"


def rmsnorm(x, g):
    xf = x.astype(jnp.float32)
    y = xf * lax.rsqrt(jnp.mean(xf * xf, axis=-1, keepdims=True) + NORM_EPS)
    return (y * g.astype(jnp.float32)).astype(x.dtype)


def modulate(x, shift, scale):
    return x * (1 + scale) + shift


def axial_angles(n_tok, dim):
    nf = dim // 4
    inv = 1.0 / (ROPE_BASE ** (jnp.arange(nf, dtype=jnp.float32) / nf))
    t = jnp.arange(n_tok)
    row = (t // GRID_W).astype(jnp.float32)
    col = (t % GRID_W).astype(jnp.float32)
    return row[:, None] * inv, col[:, None] * inv


def rope_half(x, ang):
    nf = ang.shape[-1]
    cos = jnp.cos(ang)[:, None, :]
    sin = jnp.sin(ang)[:, None, :]
    x1, x2 = x[..., :nf], x[..., nf:]
    return jnp.concatenate([x1 * cos - x2 * sin, x2 * cos + x1 * sin], axis=-1).astype(x.dtype)


def axial_rope(x, ang):
    ang_r, ang_c = ang
    half = x.shape[-1] // 2
    return jnp.concatenate([rope_half(x[..., :half], ang_r), rope_half(x[..., half:], ang_c)], axis=-1)


def context_attention(q, k, v, scale, sink=None):
    rep = q.shape[2] // k.shape[2]
    k = jnp.repeat(k, rep, axis=2)
    v = jnp.repeat(v, rep, axis=2)
    s = jnp.einsum('bqhd,bkhd->bhqk', q, k).astype(jnp.float32) * scale
    n_keys = s.shape[-1]
    if sink is not None:
        s_sink = jnp.broadcast_to(sink.astype(jnp.float32)[None, :, None, None], s.shape[:-1] + (1,))
        s = jnp.concatenate([s, s_sink], axis=-1)
    p = jax.nn.softmax(s, axis=-1)[..., :n_keys].astype(v.dtype)
    o = jnp.einsum('bhqk,bkhd->bqhd', p, v)
    return o.reshape(o.shape[0], o.shape[1], -1)


def neighbourhood_attention(p_lat, p_ctx, rpb, need_ctx):
    Bsz, S, _ = p_lat.shape
    Lc = p_ctx.shape[1]
    rows = S // GRID_W
    kh = min(WIN_H, rows)
    nb = GRID_W // NA_QBLK_W
    nk = kh * NA_KSPAN_W
    scale = HEAD_DIM ** -0.5
    q, k, v = [t.reshape(Bsz, S, NA_HEADS, HEAD_DIM) for t in jnp.split(p_lat, 3, axis=-1)]
    qc, kc, vc = [t.reshape(Bsz, Lc, NA_HEADS, HEAD_DIM) for t in jnp.split(p_ctx, 3, axis=-1)]
    r = jnp.arange(rows)
    row_idx = jnp.clip(r - kh // 2, 0, rows - kh)[:, None] + jnp.arange(kh)
    j = jnp.arange(nb)
    col_idx = jnp.clip(j * NA_QBLK_W - WIN_W // 2, 0, GRID_W - NA_KSPAN_W)[:, None] + jnp.arange(NA_KSPAN_W)

    def gather(t):
        t = t.reshape(Bsz, rows, GRID_W, NA_HEADS, HEAD_DIM)[:, row_idx][:, :, :, col_idx]
        t = t.transpose(0, 1, 3, 2, 4, 5, 6)
        return t.reshape(Bsz, rows, nb, nk, NA_HEADS, HEAD_DIM)

    kb, vb = gather(k), gather(v)
    qb = q.reshape(Bsz, rows, nb, NA_QBLK_W, NA_HEADS, HEAD_DIM)
    qcol = j[:, None] * NA_QBLK_W + jnp.arange(NA_QBLK_W)
    cstart = jnp.clip(qcol - WIN_W // 2, 0, GRID_W - WIN_W)
    kcol = col_idx[:, None, :]
    valid = (kcol >= cstart[..., None]) & (kcol < cstart[..., None] + WIN_W)
    valid = jnp.broadcast_to(valid[:, :, None, :], (nb, NA_QBLK_W, kh, NA_KSPAN_W)).reshape(nb, NA_QBLK_W, nk)
    dr = row_idx - r[:, None] + (WIN_H - 1)
    dc = jnp.clip(kcol - qcol[..., None] + (WIN_W - 1), 0, 2 * WIN_W - 2)
    bias = rpb[:, dr[:, None, None, :, None], dc[None, :, :, None, :]]
    bias = bias.reshape(NA_HEADS, rows, nb, NA_QBLK_W, nk).transpose(1, 2, 0, 3, 4)
    s = jnp.einsum('brnqhd,brnkhd->brnhqk', qb, kb).astype(jnp.float32) * scale + bias.astype(jnp.float32)
    s = jnp.where(valid[None, None, :, None], s, NEG_INF)
    s_ctx = jnp.einsum('brnqhd,bkhd->brnhqk', qb, kc).astype(jnp.float32) * scale
    p = jax.nn.softmax(jnp.concatenate([s, s_ctx], axis=-1), axis=-1).astype(v.dtype)
    o = (jnp.einsum('brnhqk,brnkhd->brnqhd', p[..., :nk], vb)
         + jnp.einsum('brnhqk,bkhd->brnqhd', p[..., nk:], vc))
    o = o.reshape(Bsz, S, NA_HEADS * HEAD_DIM)
    o_ctx = context_attention(qc, kc, vc, scale) if need_ctx else None
    return o, o_ctx


def window_attention(p_lat, p_ctx, sink, ang, need_ctx):
    Bsz, S, _ = p_lat.shape
    R = SWA_HEADS // SWA_KV_HEADS
    nblk = S // SWA_BLOCK
    scale = HEAD_DIM ** -0.5

    def heads(p):
        L = p.shape[1]
        q, k, v = jnp.split(p, [SWA_HEADS * HEAD_DIM, (SWA_HEADS + SWA_KV_HEADS) * HEAD_DIM], axis=-1)
        return (q.reshape(Bsz, L, SWA_HEADS, HEAD_DIM), k.reshape(Bsz, L, SWA_KV_HEADS, HEAD_DIM),
                v.reshape(Bsz, L, SWA_KV_HEADS, HEAD_DIM))

    q, k, v = heads(p_lat)
    q, k = axial_rope(q, ang), axial_rope(k, ang)
    qc, kc, vc = heads(p_ctx)
    nc = kc.shape[1]
    qb = q.reshape(Bsz, nblk, SWA_BLOCK, SWA_KV_HEADS, R, HEAD_DIM)

    def band(t):
        tp = jnp.pad(t, ((0, 0), (SWA_BLOCK, SWA_BLOCK), (0, 0), (0, 0)))
        tp = tp.reshape(Bsz, nblk + 2, SWA_BLOCK, SWA_KV_HEADS, HEAD_DIM)
        return jnp.concatenate([tp[:, :-2], tp[:, 1:-1], tp[:, 2:]], axis=2)

    kb, vb = band(k), band(v)
    nk = 3 * SWA_BLOCK
    qpos = jnp.arange(nblk)[:, None] * SWA_BLOCK + jnp.arange(SWA_BLOCK)
    kpos = (jnp.arange(nblk)[:, None] - 1) * SWA_BLOCK + jnp.arange(nk)
    valid = ((jnp.abs(qpos[:, :, None] - kpos[:, None, :]) <= SWA_WINDOW)
             & (kpos[:, None, :] >= 0) & (kpos[:, None, :] < S))
    s = jnp.einsum('bnqgrd,bnkgd->bngrqk', qb, kb).astype(jnp.float32) * scale
    s = jnp.where(valid[None, :, None, None], s, NEG_INF)
    s_ctx = jnp.einsum('bnqgrd,bkgd->bngrqk', qb, kc).astype(jnp.float32) * scale
    s_sink = jnp.broadcast_to(sink.astype(jnp.float32).reshape(1, 1, SWA_KV_HEADS, R, 1, 1), s.shape[:-1] + (1,))
    p = jax.nn.softmax(jnp.concatenate([s, s_ctx, s_sink], axis=-1), axis=-1).astype(v.dtype)
    o = (jnp.einsum('bngrqk,bnkgd->bnqgrd', p[..., :nk], vb)
         + jnp.einsum('bngrqk,bkgd->bnqgrd', p[..., nk:nk + nc], vc))
    o = o.reshape(Bsz, S, SWA_HEADS * HEAD_DIM)
    o_ctx = context_attention(qc, kc, vc, scale, sink) if need_ctx else None
    return o, o_ctx


def latent_attention(p_lat, p_ctx, g_q, g_kv, w_uq, w_ukv, ang, need_ctx):
    Bsz, S, _ = p_lat.shape
    scale = (MLA_NOPE + MLA_ROPE) ** -0.5

    def project(p, rotate):
        L = p.shape[1]
        cq, ckv, kr = jnp.split(p, [MLA_Q_LORA, MLA_Q_LORA + MLA_KV_LORA], axis=-1)
        q = (rmsnorm(cq, g_q) @ w_uq).reshape(Bsz, L, MLA_HEADS, MLA_NOPE + MLA_ROPE)
        kv = (rmsnorm(ckv, g_kv) @ w_ukv).reshape(Bsz, L, MLA_HEADS, MLA_NOPE + MLA_V)
        qn, qr = q[..., :MLA_NOPE], q[..., MLA_NOPE:]
        kn, v = kv[..., :MLA_NOPE], kv[..., MLA_NOPE:]
        kr = kr[:, :, None, :]
        if rotate:
            qr, kr = axial_rope(qr, ang), axial_rope(kr, ang)
        return qn, qr, kn, kr, v

    qn, qr, kn, kr, v = project(p_lat, True)
    qnc, qrc, knc, krc, vc = project(p_ctx, False)
    kn_all = jnp.concatenate([knc, kn], axis=1)
    kr_all = jnp.concatenate([krc, kr], axis=1)[:, :, 0]
    v_all = jnp.concatenate([vc, v], axis=1)
    nblk = S // MLA_BLOCK

    def blocks(t):
        return t.reshape(Bsz, nblk, MLA_BLOCK, *t.shape[2:]).swapaxes(0, 1)

    def attend(qs):
        qn_b, qr_b = qs
        s = (jnp.einsum('bqhd,bkhd->bhqk', qn_b, kn_all)
             + jnp.einsum('bqhd,bkd->bhqk', qr_b, kr_all)).astype(jnp.float32) * scale
        p = jax.nn.softmax(s, axis=-1).astype(v_all.dtype)
        return jnp.einsum('bhqk,bkhd->bqhd', p, v_all)

    o = lax.map(attend, (blocks(qn), blocks(qr)))
    o = o.swapaxes(0, 1).reshape(Bsz, S, MLA_HEADS * MLA_V)
    o_ctx = None
    if need_ctx:
        q_full = jnp.concatenate([qnc, qrc], axis=-1)
        k_full = jnp.concatenate([knc, jnp.broadcast_to(krc, knc.shape[:-1] + (MLA_ROPE,))], axis=-1)
        o_ctx = context_attention(q_full, k_full, vc, scale)
    return o, o_ctx


def centred_depthwise_conv(x, w, b):
    L = x.shape[1]
    pad = SSD_CONV // 2
    xp = jnp.pad(x, ((0, 0), (pad, pad), (0, 0)))
    acc = xp[:, 0:L] * w[0]
    for i in range(1, SSD_CONV):
        acc = acc + xp[:, i:i + L] * w[i]
    return jax.nn.silu(acc + b)


def ssd_scan(x, dt, a, bm, cm, h0):
    f32 = jnp.float32
    Bsz, L, H, P = x.shape
    G, N = bm.shape[2], bm.shape[3]
    nc, Q = L // SSD_CHUNK, SSD_CHUNK
    xdt = (x.astype(f32) * dt[..., None]).reshape(Bsz, nc, Q, H, P)
    bh = jnp.repeat(bm.astype(f32), H // G, axis=2).reshape(Bsz, nc, Q, H, N)
    ch = jnp.repeat(cm.astype(f32), H // G, axis=2).reshape(Bsz, nc, Q, H, N)
    cum = jnp.cumsum((dt * a).reshape(Bsz, nc, Q, H), axis=2)
    lower = jnp.tril(jnp.ones((Q, Q), dtype=bool))
    seg = jnp.exp(jnp.where(lower[None, None, :, :, None],
                            cum[:, :, :, None, :] - cum[:, :, None, :, :], -jnp.inf))
    cb = jnp.einsum('bcihn,bcjhn->bcijh', ch, bh) * seg
    y_diag = jnp.einsum('bcijh,bcjhp->bcihp', cb, xdt)
    decay_end = jnp.exp(cum[:, :, -1:, :] - cum)
    states = jnp.einsum('bcjhn,bcjh,bcjhp->bchpn', bh, decay_end, xdt)
    chunk_decay = jnp.exp(cum[:, :, -1, :])

    def step(h, inp):
        s_c, d_c = inp
        return h * d_c[:, :, None, None] + s_c, h

    h_last, h_start = lax.scan(step, h0, (jnp.moveaxis(states, 1, 0), jnp.moveaxis(chunk_decay, 1, 0)))
    h_start = jnp.moveaxis(h_start, 0, 1)
    y_off = jnp.einsum('bcihn,bchpn->bcihp', ch, h_start) * jnp.exp(cum)[..., None]
    y = (y_diag + y_off).reshape(Bsz, L, H, P)
    return y, h_last


def flip_seq(t, rev):
    return jnp.flip(t, axis=1) if rev else t


def ssd_mixer(p_lat, p_ctx, conv_w, conv_b, dt_bias, a_log, d_skip, g_norm, need_ctx):
    f32 = jnp.float32
    a = -jnp.exp(a_log.astype(f32))

    def prepare(p):
        Bsz, L, _ = p.shape
        z, xbc, dt = jnp.split(p, [SSD_INNER, SSD_INNER + SSD_CONV_CH], axis=-1)
        xbc = centred_depthwise_conv(xbc, conv_w, conv_b)
        x, bm, cm = jnp.split(xbc, [SSD_INNER, SSD_INNER + SSD_GROUPS * SSD_STATE], axis=-1)
        dt = jax.nn.softplus(dt.astype(f32).reshape(Bsz, L, 2, SSD_HEADS) + dt_bias.astype(f32))
        return (z, x.reshape(Bsz, L, SSD_HEADS, SSD_HEAD_DIM), bm.reshape(Bsz, L, SSD_GROUPS, SSD_STATE),
                cm.reshape(Bsz, L, SSD_GROUPS, SSD_STATE), dt)

    zl, xl, bl, cl, dtl = prepare(p_lat)
    zc, xc, bc, cc, dtc = prepare(p_ctx)
    Bsz = xl.shape[0]
    skip = d_skip.astype(f32)[:, None]
    y_lat = xl.astype(f32) * skip
    y_ctx = xc.astype(f32) * skip
    h0 = jnp.zeros((Bsz, SSD_HEADS, SSD_HEAD_DIM, SSD_STATE), f32)
    for direction in range(2):
        rev = direction == 1
        yc_d, h_ctx = ssd_scan(flip_seq(xc, rev), flip_seq(dtc[:, :, direction], rev), a[direction],
                               flip_seq(bc, rev), flip_seq(cc, rev), h0)
        yl_d, _ = ssd_scan(flip_seq(xl, rev), flip_seq(dtl[:, :, direction], rev), a[direction],
                           flip_seq(bl, rev), flip_seq(cl, rev), h_ctx)
        y_lat = y_lat + flip_seq(yl_d, rev)
        y_ctx = y_ctx + flip_seq(yc_d, rev)

    def gate_out(y, z):
        Bz, L = y.shape[:2]
        return rmsnorm(y.reshape(Bz, L, SSD_INNER) * jax.nn.silu(z.astype(f32)), g_norm).astype(z.dtype)

    o = gate_out(y_lat, zl)
    o_ctx = gate_out(y_ctx, zc) if need_ctx else None
    return o, o_ctx


def sq_relu_mlp(x, w1, w2):
    return jnp.square(jax.nn.relu(x @ w1)) @ w2


def setup_inputs(seed: int = 0) -> dict:
    key = jax.random.key(seed)
    ks = jax.random.split(key, 26)
    f32 = jnp.float32

    def nrm(k, shape, scale):
        return jax.random.normal(k, shape, f32) * scale

    def gain(k, shape):
        return 1.0 + 0.02 * jax.random.normal(k, shape, f32)

    dt0 = jnp.exp(jax.random.uniform(ks[16], (DEPTH, 2, SSD_HEADS), f32, math.log(1e-3), math.log(1e-1)))
    return {
        "x": nrm(ks[0], (BATCH, SEQ, D_MODEL), 1.0),
        "c": nrm(ks[1], (BATCH, D_MODEL), 1.0),
        "ctx": nrm(ks[2], (BATCH, CTX_LEN, D_MODEL), 1.0),
        "c_ctx": nrm(ks[3], (D_MODEL,), 1.0),
        "w_mod": nrm(ks[4], (DEPTH, D_MODEL, 6 * D_MODEL), 0.5 * D_MODEL ** -0.5),
        "b_mod": nrm(ks[5], (DEPTH, 6 * D_MODEL), 0.01),
        "g_norm1": gain(ks[6], (DEPTH, D_MODEL)),
        "w_in": nrm(ks[7], (DEPTH, D_MODEL, N_IN), D_MODEL ** -0.5),
        "na_rpb": nrm(ks[8], (DEPTH, NA_HEADS, 2 * WIN_H - 1, 2 * WIN_W - 1), 0.1),
        "swa_sink": nrm(ks[9], (DEPTH, SWA_HEADS), 0.5),
        "mla_g_q": gain(ks[10], (DEPTH, MLA_Q_LORA)),
        "mla_g_kv": gain(ks[11], (DEPTH, MLA_KV_LORA)),
        "mla_w_uq": nrm(ks[12], (DEPTH, MLA_Q_LORA, MLA_HEADS * (MLA_NOPE + MLA_ROPE)), MLA_Q_LORA ** -0.5),
        "mla_w_ukv": nrm(ks[13], (DEPTH, MLA_KV_LORA, MLA_HEADS * (MLA_NOPE + MLA_V)), MLA_KV_LORA ** -0.5),
        "ssd_conv_w": nrm(ks[14], (DEPTH, SSD_CONV, SSD_CONV_CH), SSD_CONV ** -0.5),
        "ssd_conv_b": nrm(ks[15], (DEPTH, SSD_CONV_CH), 0.01),
        "ssd_dt_bias": dt0 + jnp.log(-jnp.expm1(-dt0)),
        "ssd_a_log": jnp.log(jax.random.uniform(ks[17], (DEPTH, 2, SSD_HEADS), f32, 1.0, 16.0)),
        "ssd_d": 1.0 + 0.1 * jax.random.normal(ks[18], (DEPTH, SSD_HEADS), f32),
        "ssd_g_norm": gain(ks[19], (DEPTH, SSD_INNER)),
        "w_out": nrm(ks[20], (DEPTH, D_MIX, D_MODEL), D_MIX ** -0.5),
        "g_norm2": gain(ks[21], (DEPTH, D_MODEL)),
        "w_mlp1": nrm(ks[22], (DEPTH, D_MODEL, D_FF), D_MODEL ** -0.5),
        "w_mlp2": nrm(ks[23], (DEPTH, D_FF, D_MODEL), D_FF ** -0.5),
        "g_final": gain(ks[24], (D_MODEL,)),
    }


def reference(x, c, ctx, c_ctx, w_mod, b_mod, g_norm1, w_in, na_rpb, swa_sink, mla_g_q, mla_g_kv,
              mla_w_uq, mla_w_ukv, ssd_conv_w, ssd_conv_b, ssd_dt_bias, ssd_a_log, ssd_d, ssd_g_norm,
              w_out, g_norm2, w_mlp1, w_mlp2, g_final):
    S = x.shape[1]
    ang_swa = axial_angles(S, HEAD_DIM)
    ang_mla = axial_angles(S, MLA_ROPE)
    c_act = jax.nn.silu(c)[:, None, :]
    cc_act = jax.nn.silu(c_ctx)
    h, hc = x, ctx
    for l in range(DEPTH):
        need_ctx = l < DEPTH - 1
        m = jnp.split(c_act @ w_mod[l] + b_mod[l], 6, axis=-1)
        mc = jnp.split(cc_act @ w_mod[l] + b_mod[l], 6, axis=-1)

        p = modulate(rmsnorm(h, g_norm1[l]), m[0], m[1]) @ w_in[l]
        pc = modulate(rmsnorm(hc, g_norm1[l]), mc[0], mc[1]) @ w_in[l]
        pa, pb, pm, pd = jnp.split(p, IN_SPLITS, axis=-1)
        pa_c, pb_c, pm_c, pd_c = jnp.split(pc, IN_SPLITS, axis=-1)
        oa, oa_c = neighbourhood_attention(pa, pa_c, na_rpb[l], need_ctx)
        ob, ob_c = window_attention(pb, pb_c, swa_sink[l], ang_swa, need_ctx)
        om, om_c = latent_attention(pm, pm_c, mla_g_q[l], mla_g_kv[l], mla_w_uq[l], mla_w_ukv[l], ang_mla, need_ctx)
        od, od_c = ssd_mixer(pd, pd_c, ssd_conv_w[l], ssd_conv_b[l], ssd_dt_bias[l], ssd_a_log[l], ssd_d[l],
                             ssd_g_norm[l], need_ctx)
        h = h + m[2] * (jnp.concatenate([oa, ob, om, od], axis=-1) @ w_out[l])

        h = h + m[5] * sq_relu_mlp(modulate(rmsnorm(h, g_norm2[l]), m[3], m[4]), w_mlp1[l], w_mlp2[l])

        if need_ctx:
            hc = hc + mc[2] * (jnp.concatenate([oa_c, ob_c, om_c, od_c], axis=-1) @ w_out[l])
            hc = hc + mc[5] * sq_relu_mlp(modulate(rmsnorm(hc, g_norm2[l]), mc[3], mc[4]), w_mlp1[l], w_mlp2[l])
    return rmsnorm(h, g_final)
```

```cpp
#include <hip/hip_runtime.h>
#include <hip/hip_cooperative_groups.h>
#include <stdint.h>
#include <stdio.h>
namespace cg = cooperative_groups;

typedef unsigned short bf16_t;
typedef short bf16x8 __attribute__((ext_vector_type(8)));
typedef float f32x4 __attribute__((ext_vector_type(4)));
typedef float f32x16 __attribute__((ext_vector_type(16)));
typedef unsigned u32x4 __attribute__((ext_vector_type(4)));

#define DEVI __device__ __forceinline__

constexpr int SEQ = 8192, LCTX = 256, TOK = 8448, MROWS = 16896, DM = 1024, DFF = 4096, PP = 2816;
constexpr int NLAYER = 4;
constexpr int C_NAQ = 0, C_NAK = 256, C_NAV = 512, C_SWQ = 768, C_SWK = 1024, C_SWV = 1152;
constexpr int C_MCQ = 1280, C_MCKV = 1536, C_MKR = 1664, C_SZ = 1696, C_SX = 1952, C_SB = 2208, C_SC = 2464, C_SDT = 2720;
constexpr int NIN = 2728;
constexpr float LOG2E = 1.4426950408889634f;

constexpr size_t OFF_WTIN = 0;
constexpr size_t OFF_WTOUT = OFF_WTIN + (size_t)4 * PP * 1024 * 2;
constexpr size_t OFF_WT1 = OFF_WTOUT + (size_t)4 * 1024 * 1024 * 2;
constexpr size_t OFF_WT2 = OFF_WT1 + (size_t)4 * 4096 * 1024 * 2;
constexpr size_t OFF_WTUQ = OFF_WT2 + (size_t)4 * 4096 * 1024 * 2;
constexpr size_t OFF_WTUKV = OFF_WTUQ + (size_t)4 * 384 * 256 * 2;
constexpr size_t OFF_ROPE = OFF_WTUKV + (size_t)4 * 512 * 128 * 2;
constexpr size_t OFF_HC = OFF_ROPE + 32768;
constexpr size_t OFF_A = OFF_HC + (size_t)512 * 1024 * 4;
constexpr size_t OFF_P = OFF_A + (size_t)MROWS * 1024 * 2;
constexpr size_t OFF_MQ = OFF_P + (size_t)MROWS * PP * 2;
constexpr size_t OFF_MK = OFF_MQ + (size_t)MROWS * 384 * 2;
constexpr size_t OFF_VTNA = OFF_MK + (size_t)MROWS * 256 * 2;
constexpr size_t OFF_VTSWA = OFF_VTNA + (size_t)2 * 256 * TOK * 2;
constexpr size_t OFF_VTMLA = OFF_VTSWA + (size_t)2 * 128 * TOK * 2;
constexpr size_t OFF_XBC = OFF_VTMLA + (size_t)2 * 256 * TOK * 2;
constexpr size_t OFF_HID = OFF_P;
static_assert(OFF_XBC - OFF_P >= (size_t)MROWS * DFF * 2, "hid alias");
constexpr size_t OFF_XBCT = OFF_XBC + (size_t)MROWS * 768 * 2;
constexpr size_t OFF_DT = OFF_XBCT + (size_t)2 * 512 * TOK * 2;
constexpr size_t OFF_L = OFF_DT + (size_t)MROWS * 8 * 4;
constexpr size_t OFF_CD = OFF_L + (size_t)MROWS * 8 * 4;
constexpr size_t OFF_ST = OFF_CD + 8192;
constexpr size_t OFF_HS = OFF_ST + (size_t)132 * 8 * 8192 * 4;
constexpr size_t OFF_BAR = OFF_HS + (size_t)132 * 8 * 8192 * 2;
constexpr size_t OFF_MOD = OFF_BAR + 16384;
constexpr size_t OFF_PART = OFF_MOD + (size_t)4 * 3 * 6144 * 4;
constexpr size_t WS_END = OFF_PART + (size_t)8 * 512 * 1024 * 4;

struct Params {
  const float* in[25];
  float* out;
  unsigned char* ws;
  int ph_lo, ph_hi;
  int use_cg, pad;
};
enum { I_X = 0, I_C, I_CTX, I_CCTX, I_WMOD, I_BMOD, I_G1, I_WIN, I_RPB, I_SINK, I_GQ, I_GKV, I_WUQ, I_WUKV, I_CONVW, I_CONVB,
       I_DTB, I_ALOG, I_SSDD, I_SSDG, I_WOUT, I_G2, I_W1, I_W2, I_GF };

DEVI unsigned short f2bf(float f) {
  unsigned u = __float_as_uint(f);
  u += 0x7fffu + ((u >> 16) & 1u);
  return (unsigned short)(u >> 16);
}
DEVI float bf2f(unsigned short h) { return __uint_as_float(((unsigned)h) << 16); }
typedef float f32x2_t __attribute__((ext_vector_type(2)));
typedef __bf16 bf16x2_t __attribute__((ext_vector_type(2)));
DEVI unsigned pk2(float lo, float hi) { f32x2_t v = {lo, hi}; bf16x2_t b = __builtin_convertvector(v, bf16x2_t); return __builtin_bit_cast(unsigned, b); }
DEVI float bflo(unsigned u) { return __uint_as_float(u << 16); }
DEVI float bfhi(unsigned u) { return __uint_as_float(u & 0xffff0000u); }
DEVI float siluf(float x) { return x / (1.f + __expf(-x)); }
DEVI float softplusf(float x) {
  if (x > 20.f) return x;
  float e = __expf(x);
  return e < 0.01f ? e * (1.f - e * (0.5f - e * (0.33333334f - 0.25f * e))) : __logf(1.f + e);
}
DEVI float2 cossin_reduced(float ang) {
  float n = rintf(ang * 0.15915494309189535f);
  float r = fmaf(-n, 6.28318548202514648f, ang);
  r = fmaf(-n, -1.74845553e-07f, r);
  return make_float2(__cosf(r), __sinf(r));
}
DEVI float ex2(float x) { return __builtin_amdgcn_exp2f(x); }
DEVI float max3f(float a, float b, float c) { float r; asm("v_max3_f32 %0, %1, %2, %3" : "=v"(r) : "v"(a), "v"(b), "v"(c)); return r; }
DEVI f32x16 mfma32(bf16x8 a, bf16x8 b, f32x16 c) { return __builtin_amdgcn_mfma_f32_32x32x16_bf16(a, b, c, 0, 0, 0); }
DEVI f32x4 mfma16(bf16x8 a, bf16x8 b, f32x4 c) { return __builtin_amdgcn_mfma_f32_16x16x32_bf16(a, b, c, 0, 0, 0); }
DEVI bf16x8 ld8(const bf16_t* p) { return *(const bf16x8*)p; }
DEVI bf16x8 mk8(unsigned a, unsigned b, unsigned c, unsigned d) {
  uint4 u = make_uint4(a, b, c, d);
  return __builtin_bit_cast(bf16x8, u);
}
DEVI bf16x8 ld4x2(const bf16_t* p0, const bf16_t* p1) {
  uint2 a = *(const uint2*)p0;
  uint2 b = *(const uint2*)p1;
  return mk8(a.x, a.y, b.x, b.y);
}
DEVI int rtid() { int t = threadIdx.x; asm volatile("" : "+v"(t)); return t; }
DEVI int otid() { int t = threadIdx.x & 255; asm volatile("" : "+v"(t)); return t; }
DEVI int vbid() { return blockIdx.x * 2 + (rtid() >> 8); }
DEVI int nvb() { return gridDim.x * 2; }
DEVI float wave_sum(float v) {
#pragma unroll
  for (int o = 32; o >= 1; o >>= 1) v += __shfl_xor(v, o);
  return v;
}
DEVI float* hrow(const Params& P, int m) {
  int b = m / TOK, t = m - b * TOK;
  return t < LCTX ? (float*)(P.ws + OFF_HC) + (size_t)(b * LCTX + t) * DM : P.out + (size_t)(b * SEQ + t - LCTX) * DM;
}
DEVI int modrow(int m) {
  int b = m / TOK, t = m - b * TOK;
  return t < LCTX ? 2 : b;
}
DEVI const float* modvec(const Params& P, int l, int r, int which) {
  return (const float*)(P.ws + OFF_MOD) + ((size_t)(l * 3 + r) * 6 + which) * DM;
}


#define LAS __attribute__((address_space(3)))
#define XB_TMO      128
#define XB_XCNT(j)  (256  + 64 * (j))
#define XB_XSUB(j)  (1280 + 64 * (j))
#define XB_XGEN(j)  (2304 + 64 * (j))
#define XB_TOP      3328
#define XB_TOPGEN   3392
#define XCD_BAR_WORDS 3456
#define XB_SPIN_CAP (1u << 20)
DEVI unsigned xb_ld(unsigned* p) { return __hip_atomic_load(p, __ATOMIC_RELAXED, __HIP_MEMORY_SCOPE_AGENT); }
DEVI unsigned xb_add(unsigned* p, unsigned v) { return __hip_atomic_fetch_add(p, v, __ATOMIC_RELAXED, __HIP_MEMORY_SCOPE_AGENT); }
DEVI unsigned xb_xcc_id() { return (unsigned)__builtin_amdgcn_s_getreg((3 << 11) | 20) & 0xFu; }
#define XB_SPIN(cond, bar) do { unsigned _sp = 0; while (cond) { __builtin_amdgcn_s_sleep(1); \
    if ((++_sp & 255u) == 0u) { if (xb_ld(&(bar)[XB_TMO])) break; if (_sp > XB_SPIN_CAP) { atomicAdd(&(bar)[XB_TMO], 1u); break; } } } } while (0)
DEVI void xcd_barrier_complete(unsigned* bar, unsigned x, unsigned& nloc, unsigned& nx) {
  const unsigned G = gridDim.x;
  unsigned sum, cnt, mine, sp = 0u;
  for (;;) {
    sum = 0u; cnt = 0u; mine = 0u;
#pragma unroll
    for (unsigned j = 0; j < 16; ++j) { const unsigned c = xb_ld(&bar[XB_XCNT(j)]); sum += c; cnt += (c > 0u) ? 1u : 0u; mine = (j == x) ? c : mine; }
    if (sum == G) break;
    __builtin_amdgcn_s_sleep(1);
    if ((++sp & 255u) == 0u) { if (xb_ld(&bar[XB_TMO])) break; if (sp > XB_SPIN_CAP) { atomicAdd(&bar[XB_TMO], 1u); break; } }
  }
  nloc = mine > 0u ? mine : 1u; nx = cnt > 0u ? cnt : 1u;
}
DEVI void xcd_barrier(unsigned* bar, unsigned x, volatile unsigned* st) {
  asm volatile("s_waitcnt vmcnt(0)" ::: "memory");
  __syncthreads();
  if (threadIdx.x == 0) {
    __builtin_amdgcn_s_waitcnt(0);
    unsigned nloc = st[0], nx = st[1];
    if (nloc == 0u) { xcd_barrier_complete(bar, x, nloc, nx); st[0] = nloc; st[1] = nx; }
    const unsigned old = xb_add(&bar[XB_XSUB(x)], 1u);
    const unsigned gen = old / nloc;
    if (old + 1u == (gen + 1u) * nloc) {
      __builtin_amdgcn_fence(__ATOMIC_RELEASE, "agent");
      asm volatile("s_waitcnt vmcnt(0)" ::: "memory");
      const unsigned og = xb_add(&bar[XB_TOP], 1u);
      const unsigned tg = og / nx;
      if (og + 1u == (tg + 1u) * nx) xb_add(&bar[XB_TOPGEN], 1u);
      else XB_SPIN(xb_ld(&bar[XB_TOPGEN]) == tg, bar);
      __builtin_amdgcn_fence(__ATOMIC_ACQUIRE, "agent");
      xb_add(&bar[XB_XGEN(x)], 1u);
      asm volatile("s_waitcnt vmcnt(0)" ::: "memory");
    } else {
      XB_SPIN(xb_ld(&bar[XB_XGEN(x)]) == gen, bar);
      __builtin_amdgcn_fence(__ATOMIC_ACQUIRE, "agent");
      asm volatile("s_waitcnt vmcnt(0)" ::: "memory");
    }
  }
  __syncthreads();
}

namespace pg8 {
#define PG8_LAS __attribute__((address_space(3)))
typedef unsigned short bf16_t;
typedef short bf16x8 __attribute__((ext_vector_type(8)));
typedef float f32x4 __attribute__((ext_vector_type(4)));
typedef unsigned u32x4 __attribute__((ext_vector_type(4)));
constexpr int BM = 256, BK = 64, HALF = 128, HTB = HALF * BK * 2  , STAGE_BYTES = 8 * HTB, NXCD = 8, WGM = 8;

__host__ __device__ __forceinline__ int lds_byte(int r, int c) { const int st = (r >> 4) * 2 + (c >> 5), rr = r & 15, cc = c & 31, ob = rr * 64 + cc * 2; return st * 1024 + (ob ^ (((ob >> 9) & 1) << 5)); }
__host__ __device__ __forceinline__ void stage_rc(int b, int& R, int& C) { const int st = b / 1024, sb = b % 1024, swz = sb ^ (((sb >> 9) & 1) << 5); R = (st >> 1) * 16 + swz / 64; C = (st & 1) * 32 + (swz % 64) / 2; }
__host__ __device__ __forceinline__ int perm32(int rho) { const int n = rho >> 4, i = rho & 15; return 8 * (i >> 2) + 4 * n + (i & 3); }

struct Unit { int pm, pn; };
struct Gemm { const bf16_t* A; const bf16_t* Bt; int M, N, K; };

struct MySched {
    int nM, nN, nwg, G, c, lat;
    __device__ __forceinline__ void init(int nM_, int nN_, int G_, int c_, int lat_) { nM = nM_; nN = nN_; nwg = nM * nN; G = G_; c = c_; lat = lat_; }
    __device__ __forceinline__ bool next(int i, Unit& u) const {
        const long L = (long)i * G + c; if (L >= nwg) return false;
        int wgid = (int)L; { const int q = nwg / NXCD, r = nwg % NXCD, xcd = wgid % NXCD, off = wgid / NXCD; wgid = (xcd < r ? xcd * (q + 1) : r * (q + 1) + (xcd - r) * q) + off; }
        const int nig = WGM * nN, gid = wgid / nig, fm = gid * WGM, gsz = (nM - fm) < WGM ? (nM - fm) : WGM;
        int pm = fm + ((wgid % nig) % gsz); u.pn = (wgid % nig) / gsz;
        u.pm = lat ? ((pm >> 5) * 33 + 1 + (pm & 31)) : pm;
        return true;
    }
    __device__ __forceinline__ void a_ready(const Unit&) const {}
    __device__ __forceinline__ void done(const Unit&) const {}
};
__device__ __forceinline__ unsigned cvtpk(float lo, float hi) { typedef float f2 __attribute__((ext_vector_type(2))); typedef __bf16 b2 __attribute__((ext_vector_type(2))); f2 v = {lo, hi}; b2 b = __builtin_convertvector(v, b2); return __builtin_bit_cast(unsigned, b); }
template <int ACT> struct EpiStore {
    static constexpr bool PERM = true, AFTER_DRAIN = false;
    bf16_t* O; int ldc;
    __device__ __forceinline__ void operator()(const f32x4 (&acc)[2][2][4][2], const Unit& u, int wr, int wc, int fr, int fq) const {
        const int row0 = u.pm * BM + wr * 64 + fr, col0 = u.pn * BM + wc * 32 + 8 * fq;
#pragma unroll
        for (int ai = 0; ai < 2; ++ai)
#pragma unroll
            for (int m = 0; m < 4; ++m) { bf16_t* rowp = O + (size_t)(row0 + ai * HALF + m * 16) * ldc + col0;
#pragma unroll
                for (int bj = 0; bj < 2; ++bj) { f32x4 v0 = acc[ai][bj][m][0], v1 = acc[ai][bj][m][1];
                    if (ACT == 1) {
#pragma unroll
                        for (int e = 0; e < 4; ++e) { float a = v0[e] > 0.f ? v0[e] : 0.f, b = v1[e] > 0.f ? v1[e] : 0.f; v0[e] = a * a; v1[e] = b * b; } }
                    u32x4 w; w.x = cvtpk(v0[0], v0[1]); w.y = cvtpk(v0[2], v0[3]); w.z = cvtpk(v1[0], v1[1]); w.w = cvtpk(v1[2], v1[3]);
                    *(u32x4*)(rowp + bj * HALF) = w; } }
    }
};
struct EpiRes {
    static constexpr bool PERM = true, AFTER_DRAIN = false;
    float* out; float* hc; const float* gvec; const float* rdlat;
    __device__ __forceinline__ void operator()(const f32x4 (&acc)[2][2][4][2], const Unit& u, int wr, int wc, int fr, int fq) const {
        const int bb = u.pm / 33, tt = u.pm - bb * 33;
        const int r = tt == 0 ? 2 : bb;
        const int col0 = u.pn * BM + wc * 32 + 8 * fq;
        float* base = tt == 0 ? hc + (size_t)(bb * 256) * 1024 : out + (size_t)(bb * 8192 + (tt - 1) * 256) * 1024;
        const float* gp = gvec + (size_t)r * 6144 + col0;
        float* rowb = base + (size_t)(wr * 64 + fr) * 1024 + col0;
        const float* rowr = (tt == 0) ? rowb : rdlat + (rowb - out);
#pragma unroll
        for (int bj = 0; bj < 2; ++bj)
#pragma unroll
            for (int n = 0; n < 2; ++n) { const f32x4 gv = *(const f32x4*)(gp + bj * HALF + 4 * n);
#pragma unroll
                for (int ai = 0; ai < 2; ++ai)
#pragma unroll
                    for (int m = 0; m < 4; ++m) { const size_t off = (size_t)(ai * HALF + m * 16) * 1024 + bj * HALF + 4 * n; f32x4 hv = *(const f32x4*)(rowr + off); hv = hv + gv * acc[ai][bj][m][n]; *(f32x4*)(rowb + off) = hv; } }
    }
};

template <class Epi, class Sched, bool ALIGN_EPI = false, bool SP2 = false>
__device__ __forceinline__ void gemm_phase(PG8_LAS unsigned char* lds, const Gemm g, const Sched& S, const Epi& E) {
    int tid = threadIdx.x; asm volatile("" : "+v"(tid));
    const int wid = __builtin_amdgcn_readfirstlane(tid >> 6), lane = tid & 63, wr = wid >> 2, wc = wid & 3, fr = lane & 15, fq = lane >> 4;
    const int K = g.K, nt = K / BK;
    unsigned voffA[2], voffB[2];
#pragma unroll
    for (int i = 0; i < 2; ++i) { int R, C; stage_rc(tid * 16 + i * 8192, R, C); const int Rb = Epi::PERM ? ((R & ~31) + perm32(R & 31)) : R;
        voffA[i] = (unsigned)(R * K + C) * 2u; voffB[i] = (unsigned)(Rb * K + C) * 2u; }
    const size_t kstep = (size_t)(BK * 2);
    const size_t hstep = (size_t)HALF * K * 2;
    const size_t tstep = 2 * hstep;
    const unsigned ldsw = (unsigned)wid * 1024u;
    const int aoff = lds_byte(wr * 64 + fr, fq * 8), boff = lds_byte(wc * 32 + fr, fq * 8);
#define PG8_SA(b, h) (((b) * 2 + (h)) * HTB)
#define PG8_SB(b, h) ((4 + (b) * 2 + (h)) * HTB)
#define PG8_STAGE(bufoff, gbase, voff) do { _Pragma("unroll") for (int _i = 0; _i < 2; ++_i) \
        __builtin_amdgcn_global_load_lds((const unsigned*)((const char*)(gbase) + (voff)[_i]), (PG8_LAS unsigned*)(lds + (bufoff) + ldsw + _i * 8192), 16, 0, 0); } while (0)
#define PG8_LDA(dst, b, h) do { _Pragma("unroll") for (int m = 0; m < 4; ++m) _Pragma("unroll") for (int k = 0; k < 2; ++k) dst[m][k] = *(const PG8_LAS bf16x8*)(lds + PG8_SA(b, h) + aoff + m * 2048 + k * 1024); } while (0)
#define PG8_LDB(dst, b, h) do { _Pragma("unroll") for (int n = 0; n < 2; ++n) _Pragma("unroll") for (int k = 0; k < 2; ++k) dst[n][k] = *(const PG8_LAS bf16x8*)(lds + PG8_SB(b, h) + boff + n * 2048 + k * 1024); } while (0)
#define PG8_MMA(ai, bj, At, Bt) do { __builtin_amdgcn_s_setprio(1); _Pragma("unroll") for (int m = 0; m < 4; ++m) _Pragma("unroll") for (int n = 0; n < 2; ++n) _Pragma("unroll") for (int k = 0; k < 2; ++k) \
        acc[ai][bj][m][n] = __builtin_amdgcn_mfma_f32_16x16x32_bf16(Bt[n][k], At[m][k], acc[ai][bj][m][n], 0, 0, 0); __builtin_amdgcn_s_setprio(0); } while (0)
#define PG8_WAIT_V(n) asm volatile("s_waitcnt vmcnt(" #n ")" ::: "memory")
#define PG8_WAIT_L(n) asm volatile("s_waitcnt lgkmcnt(" #n ")" ::: "memory")
#define PG8_BAR __builtin_amdgcn_s_barrier()
#define PG8_SCHED __builtin_amdgcn_sched_barrier(0)
    Unit cur, nxt; int ui = 0;
    if (!S.next(0, cur)) return;
    f32x4 acc[2][2][4][2];
#pragma unroll
    for (int a = 0; a < 2; ++a)
#pragma unroll
        for (int b = 0; b < 2; ++b)
#pragma unroll
            for (int m = 0; m < 4; ++m)
#pragma unroll
                for (int n = 0; n < 2; ++n) acc[a][b][m][n] = (f32x4){0.f, 0.f, 0.f, 0.f};
    bf16x8 At[4][2], B0[2][2], B1[2][2];
    const char* cA = (const char*)g.A + (size_t)cur.pm * tstep; const char* cB = (const char*)g.Bt + (size_t)cur.pn * tstep;
    S.a_ready(cur);
    if constexpr (SP2) {
        PG8_STAGE(PG8_SB(0, 0), cB, voffB); PG8_STAGE(PG8_SB(0, 1), cB + hstep, voffB); PG8_STAGE(PG8_SA(0, 0), cA, voffA); PG8_STAGE(PG8_SA(0, 1), cA + hstep, voffA);
        if (wr == 1) PG8_BAR;
        PG8_WAIT_V(2); PG8_BAR;
        PG8_STAGE(PG8_SB(1, 0), cB + kstep, voffB); PG8_STAGE(PG8_SA(1, 0), cA + kstep, voffA); PG8_STAGE(PG8_SB(1, 1), cB + hstep + kstep, voffB);
        PG8_WAIT_V(6); PG8_BAR;
    } else {
        PG8_STAGE(PG8_SB(0, 0), cB, voffB); PG8_STAGE(PG8_SA(0, 0), cA, voffA); PG8_STAGE(PG8_SB(0, 1), cB + hstep, voffB); PG8_STAGE(PG8_SA(0, 1), cA + hstep, voffA);
        if (wr == 1) PG8_BAR;
        PG8_WAIT_V(4); PG8_BAR;
        PG8_STAGE(PG8_SB(1, 0), cB + kstep, voffB); PG8_STAGE(PG8_SA(1, 0), cA + kstep, voffA); PG8_STAGE(PG8_SB(1, 1), cB + hstep + kstep, voffB);
        PG8_WAIT_V(6); PG8_BAR;
    }
    for (;;) {
        const bool has_next = S.next(ui + 1, nxt);
        const char* nA = has_next ? (const char*)g.A + (size_t)nxt.pm * tstep : cA; const char* nB = has_next ? (const char*)g.Bt + (size_t)nxt.pn * tstep : cB;
        for (int t = 0; t < nt; t += 2) {
            const bool last = (t == nt - 2);
            const char* a1 = cA + (size_t)(t + 1) * kstep;
            const char* a2 = last ? nA : cA + (size_t)(t + 2) * kstep; const char* b2 = last ? nB : cB + (size_t)(t + 2) * kstep;
            const char* a3 = a2 + kstep; const char* b3 = b2 + kstep;
            if (last && has_next) S.a_ready(nxt);
            if constexpr (SP2) {
            PG8_LDB(B0, 0, 0); PG8_LDB(B1, 0, 1); PG8_SCHED; PG8_LDA(At, 0, 0); PG8_STAGE(PG8_SA(1, 1), a1 + hstep, voffA);
            PG8_WAIT_V(8); PG8_WAIT_L(0); PG8_BAR; PG8_MMA(0, 0, At, B0); PG8_MMA(0, 1, At, B1); PG8_BAR; PG8_SCHED;
            PG8_LDA(At, 0, 1); PG8_STAGE(PG8_SB(0, 0), b2, voffB); PG8_STAGE(PG8_SB(0, 1), b2 + hstep, voffB); PG8_STAGE(PG8_SA(0, 0), a2, voffA);
            PG8_WAIT_V(8); PG8_WAIT_L(0); PG8_BAR; PG8_MMA(1, 0, At, B0); PG8_MMA(1, 1, At, B1); PG8_BAR; PG8_SCHED;
            PG8_LDB(B0, 1, 0); PG8_LDB(B1, 1, 1); PG8_SCHED; PG8_LDA(At, 1, 0); PG8_STAGE(PG8_SA(0, 1), a2 + hstep, voffA);
            PG8_WAIT_V(8); PG8_WAIT_L(0); PG8_BAR; PG8_MMA(0, 0, At, B0); PG8_MMA(0, 1, At, B1); PG8_BAR; PG8_SCHED;
            PG8_LDA(At, 1, 1); PG8_STAGE(PG8_SB(1, 0), b3, voffB); PG8_STAGE(PG8_SB(1, 1), b3 + hstep, voffB); PG8_STAGE(PG8_SA(1, 0), a3, voffA);
            PG8_WAIT_V(8); PG8_WAIT_L(0); PG8_BAR; PG8_MMA(1, 0, At, B0); PG8_MMA(1, 1, At, B1); PG8_BAR; PG8_SCHED;
            } else {
            PG8_LDB(B0, 0, 0); PG8_SCHED; PG8_LDA(At, 0, 0); PG8_STAGE(PG8_SA(1, 1), a1 + hstep, voffA);
            PG8_WAIT_L(8); PG8_BAR; PG8_WAIT_L(0); PG8_MMA(0, 0, At, B0); PG8_BAR; PG8_SCHED;
            PG8_LDB(B1, 0, 1); PG8_STAGE(PG8_SB(0, 0), b2, voffB);
            PG8_BAR; PG8_WAIT_L(0); PG8_MMA(0, 1, At, B1); PG8_BAR;
            PG8_LDA(At, 0, 1); PG8_STAGE(PG8_SA(0, 0), a2, voffA);
            PG8_BAR; PG8_WAIT_L(0); PG8_MMA(1, 0, At, B0); PG8_BAR; PG8_SCHED;
            PG8_STAGE(PG8_SB(0, 1), b2 + hstep, voffB);
            PG8_WAIT_V(6); PG8_BAR; PG8_MMA(1, 1, At, B1); PG8_BAR;
            PG8_LDB(B0, 1, 0); PG8_SCHED; PG8_LDA(At, 1, 0); PG8_STAGE(PG8_SA(0, 1), a2 + hstep, voffA);
            PG8_WAIT_L(8); PG8_BAR; PG8_WAIT_L(0); PG8_MMA(0, 0, At, B0); PG8_BAR; PG8_SCHED;
            PG8_LDB(B1, 1, 1); PG8_STAGE(PG8_SB(1, 0), b3, voffB);
            PG8_BAR; PG8_WAIT_L(0); PG8_MMA(0, 1, At, B1); PG8_BAR;
            PG8_LDA(At, 1, 1); PG8_STAGE(PG8_SA(1, 0), a3, voffA);
            PG8_BAR; PG8_WAIT_L(0); PG8_MMA(1, 0, At, B0); PG8_BAR; PG8_SCHED;
            PG8_STAGE(PG8_SB(1, 1), b3 + hstep, voffB);
            PG8_WAIT_V(6); PG8_BAR; PG8_MMA(1, 1, At, B1); PG8_BAR;
            }
        }
        if constexpr (ALIGN_EPI) { if (wr == 0) PG8_BAR; }
        if constexpr (!Epi::AFTER_DRAIN) { E(acc, cur, wr, wc, fr, fq); S.done(cur); }
        if (!has_next) break;
#pragma unroll
        for (int a = 0; a < 2; ++a)
#pragma unroll
            for (int b = 0; b < 2; ++b)
#pragma unroll
                for (int m = 0; m < 4; ++m)
#pragma unroll
                    for (int n = 0; n < 2; ++n) acc[a][b][m][n] = (f32x4){0.f, 0.f, 0.f, 0.f};
        cur = nxt; cA = nA; cB = nB; ++ui;
        if constexpr (ALIGN_EPI) { if (wr == 1) PG8_BAR; }
    }
    PG8_WAIT_V(0);
    if constexpr (!ALIGN_EPI) { if (wr == 0) PG8_BAR; }
    PG8_BAR;
    if constexpr (Epi::AFTER_DRAIN) { E.fused(acc, cur, wr, wc, fr, fq, lds, wid, lane); S.done(cur); }
#undef PG8_SA
#undef PG8_SB
#undef PG8_STAGE
#undef PG8_LDA
#undef PG8_LDB
#undef PG8_MMA
#undef PG8_WAIT_V
#undef PG8_WAIT_L
#undef PG8_BAR
#undef PG8_SCHED
}
}

struct TrJob { const float* W; bf16_t* Wt; int K, N, tk, tn; const float* gk; };
DEVI TrJob tr_job(const Params& P, int u) {
  TrJob j;
  j.gk = nullptr;
  int l = u / 3048, r = u % 3048;
  if (r < 704) { j.W = P.in[I_WIN] + (size_t)l * 1024 * NIN; j.K = 1024; j.N = NIN; j.Wt = (bf16_t*)(P.ws + OFF_WTIN) + (size_t)l * PP * 1024; j.tk = r / 44; j.tn = r % 44; }
  else if ((r -= 704) < 256) { j.W = P.in[I_WOUT] + (size_t)l * 1024 * 1024; j.K = 1024; j.N = 1024; j.Wt = (bf16_t*)(P.ws + OFF_WTOUT) + (size_t)l * 1024 * 1024; j.tk = r / 16; j.tn = r % 16; }
  else if ((r -= 256) < 1024) { j.W = P.in[I_W1] + (size_t)l * 1024 * 4096; j.K = 1024; j.N = 4096; j.Wt = (bf16_t*)(P.ws + OFF_WT1) + (size_t)l * 4096 * 1024; j.tk = r / 64; j.tn = r % 64; }
  else if ((r -= 1024) < 1024) { j.W = P.in[I_W2] + (size_t)l * 4096 * 1024; j.K = 4096; j.N = 1024; j.Wt = (bf16_t*)(P.ws + OFF_WT2) + (size_t)l * 1024 * 4096; j.tk = r / 16; j.tn = r % 16; }
  else if ((r -= 1024) < 24) { j.W = P.in[I_WUQ] + (size_t)l * 256 * 384; j.K = 256; j.N = 384; j.Wt = (bf16_t*)(P.ws + OFF_WTUQ) + (size_t)l * 384 * 256; j.tk = r / 6; j.tn = r % 6; j.gk = P.in[I_GQ] + l * 256; }
  else { r -= 24; j.W = P.in[I_WUKV] + (size_t)l * 128 * 512; j.K = 128; j.N = 512; j.Wt = (bf16_t*)(P.ws + OFF_WTUKV) + (size_t)l * 512 * 128; j.tk = r / 8; j.tn = r % 8; j.gk = P.in[I_GKV] + l * 128; }
  return j;
}
DEVI void tr_load(const TrJob& j, int tid, float4 (&v)[4]) {
  const int r = tid >> 4, c4 = (tid & 15) * 4;
  const int n = j.tn * 64 + c4;
#pragma unroll
  for (int i = 0; i < 4; ++i)
    v[i] = (n < j.N) ? *(const float4*)(j.W + (size_t)(j.tk * 64 + r + 16 * i) * j.N + n) : make_float4(0.f, 0.f, 0.f, 0.f);
}
DEVI void tr_lds(int tid, float* tile, const float4 (&v)[4]) {
  const int r = tid >> 4, c4 = (tid & 15) * 4;
#pragma unroll
  for (int i = 0; i < 4; ++i) { float* tp = tile + (r + 16 * i) * 65 + c4; tp[0] = v[i].x; tp[1] = v[i].y; tp[2] = v[i].z; tp[3] = v[i].w; }
}
DEVI void tr_store(const TrJob& j, int tid, const float* tile) {
  const int kc = tid & 7;
#pragma unroll
  for (int i = 0; i < 2; ++i) {
    int nl = (tid >> 3) + 32 * i;
    const float* tp = tile + (kc * 8) * 65 + nl;
    float g0 = 1.f, g1 = 1.f, g2 = 1.f, g3 = 1.f, g4 = 1.f, g5 = 1.f, g6 = 1.f, g7 = 1.f;
    if (j.gk) { const float* gp = j.gk + j.tk * 64 + kc * 8; g0 = gp[0]; g1 = gp[1]; g2 = gp[2]; g3 = gp[3]; g4 = gp[4]; g5 = gp[5]; g6 = gp[6]; g7 = gp[7]; }
    uint4 w;
    w.x = pk2(tp[0 * 65] * g0, tp[1 * 65] * g1);
    w.y = pk2(tp[2 * 65] * g2, tp[3 * 65] * g3);
    w.z = pk2(tp[4 * 65] * g4, tp[5 * 65] * g5);
    w.w = pk2(tp[6 * 65] * g6, tp[7 * 65] * g7);
    *(uint4*)(j.Wt + (size_t)(j.tn * 64 + nl) * j.K + j.tk * 64 + kc * 8) = w;
  }
}

DEVI void phase_prologue(const Params& P, unsigned char* smem) {
  const int tid = otid();
  {
    float* tile0 = (float*)smem;
    float* tile1 = tile0 + 64 * 65;
    for (int u = vbid(); u < 4 * 3048; u += 2 * nvb()) {
      const int u1 = u + nvb();
      const bool has1 = u1 < 4 * 3048;
      TrJob j0 = tr_job(P, u), j1 = tr_job(P, has1 ? u1 : u);
      float4 v0[4], v1[4];
      tr_load(j0, tid, v0);
      tr_load(j1, tid, v1);
      tr_lds(tid, tile0, v0);
      tr_lds(tid, tile1, v1);
      __syncthreads();
      tr_store(j0, tid, tile0);
      if (has1) tr_store(j1, tid, tile1);
      __syncthreads();
    }
  }
  {
    float* sc = (float*)smem;
    float* red = sc + 3 * 1024;
    for (int i = tid; i < 3 * 1024; i += 256) {
      int r = i >> 10, k = i & 1023;
      float v = (r < 2) ? P.in[I_C][r * 1024 + k] : P.in[I_CCTX][k];
      sc[i] = siluf(v);
    }
    __syncthreads();
    const int w = tid >> 6, lane = tid & 63, rg = lane >> 4, c4 = (lane & 15) * 4;
    float* MOD = (float*)(P.ws + OFF_MOD);
    for (int u = vbid(); u < 4 * 96; u += nvb()) {
      const int l = u / 96, cgp = u - l * 96;
      const int kb = w * 256 + rg;
      const float* W = P.in[I_WMOD] + ((size_t)l * 1024 + kb) * 6144 + cgp * 64 + c4;
      float4 a0 = make_float4(0.f, 0.f, 0.f, 0.f), a1 = a0, a2 = a0;
#pragma unroll 1
      for (int ib = 0; ib < 64; ib += 16) {
        float4 wv[16];
#pragma unroll
        for (int i = 0; i < 16; ++i) wv[i] = *(const float4*)(W + (size_t)(ib + i) * 4 * 6144);
#pragma unroll
        for (int i = 0; i < 16; ++i) {
          const int k = kb + 4 * (ib + i);
          float s0 = sc[k], s1 = sc[1024 + k], s2 = sc[2048 + k];
          a0.x += s0 * wv[i].x; a0.y += s0 * wv[i].y; a0.z += s0 * wv[i].z; a0.w += s0 * wv[i].w;
          a1.x += s1 * wv[i].x; a1.y += s1 * wv[i].y; a1.z += s1 * wv[i].z; a1.w += s1 * wv[i].w;
          a2.x += s2 * wv[i].x; a2.y += s2 * wv[i].y; a2.z += s2 * wv[i].z; a2.w += s2 * wv[i].w;
        }
      }
#pragma unroll
      for (int o = 16; o <= 32; o <<= 1) {
        a0.x += __shfl_xor(a0.x, o); a0.y += __shfl_xor(a0.y, o); a0.z += __shfl_xor(a0.z, o); a0.w += __shfl_xor(a0.w, o);
        a1.x += __shfl_xor(a1.x, o); a1.y += __shfl_xor(a1.y, o); a1.z += __shfl_xor(a1.z, o); a1.w += __shfl_xor(a1.w, o);
        a2.x += __shfl_xor(a2.x, o); a2.y += __shfl_xor(a2.y, o); a2.z += __shfl_xor(a2.z, o); a2.w += __shfl_xor(a2.w, o);
      }
      if (rg == 0) {
        *(float4*)(red + (w * 3 + 0) * 64 + c4) = a0;
        *(float4*)(red + (w * 3 + 1) * 64 + c4) = a1;
        *(float4*)(red + (w * 3 + 2) * 64 + c4) = a2;
      }
      __syncthreads();
      if (tid < 192) {
        int rr = tid >> 6, c = tid & 63;
        float sum = red[(0 * 3 + rr) * 64 + c] + red[(1 * 3 + rr) * 64 + c] + red[(2 * 3 + rr) * 64 + c] + red[(3 * 3 + rr) * 64 + c];
        sum += P.in[I_BMOD][l * 6144 + cgp * 64 + c];
        MOD[(size_t)(l * 3 + rr) * 6144 + cgp * 64 + c] = sum;
      }
      __syncthreads();
    }
  }
  {
    int gt = vbid() * 256 + tid;
    if (gt < 128 * 16) {
      int pos = gt >> 4, i = gt & 15;
      float inv = exp2f(-(float)i * (13.287712379549449f / 16.f));
      float ang = (float)pos * inv;
      ((float2*)(P.ws + OFF_ROPE))[gt] = cossin_reduced(ang);
    } else if (gt < 128 * 16 + 128 * 8) {
      int g2 = gt - 128 * 16;
      int pos = g2 >> 3, i = g2 & 7;
      float inv = exp2f(-(float)i * (13.287712379549449f / 8.f));
      float ang = (float)pos * inv;
      ((float2*)(P.ws + OFF_ROPE + 16384))[g2] = cossin_reduced(ang);
    }
  }
  {
    const size_t stride = (size_t)nvb() * 256;
    const float4* cs = (const float4*)P.in[I_CTX];
    float4* cd = (float4*)(P.ws + OFF_HC);
    const size_t c4 = (size_t)2 * LCTX * DM / 4;
    for (size_t i = (size_t)vbid() * 256 + tid; i < c4; i += stride) cd[i] = cs[i];
  }
}

DEVI void phase_norm(const Params& P, int l, const float* g, int which0, bool pend, const float* latsrc) {
  const int tid = otid(), w = tid >> 6, lane = tid & 63;
  bf16_t* A = (bf16_t*)(P.ws + OFF_A);
  const int nw = nvb() * 4;
  auto load_row = [&](int m, float4 (&v)[4]) {
    const int r = modrow(m);
    const float* hr = (r == 2) ? hrow(P, m) : latsrc + (hrow(P, m) - P.out);
#pragma unroll
    for (int j = 0; j < 4; ++j) v[j] = *(const float4*)(hr + j * 256 + lane * 4);
    if (pend && r == 2) {
      int bb = m / TOK, t = m - bb * TOK;
      const float* pp = (const float*)(P.ws + OFF_PART) + (size_t)(bb * 256 + t) * 1024 + lane * 4;
#pragma unroll 1
      for (int ks = 0; ks < 8; ++ks) {
#pragma unroll
        for (int j = 0; j < 4; ++j) {
          float4 a = *(const float4*)(pp + (size_t)ks * 512 * 1024 + j * 256);
          v[j].x += a.x; v[j].y += a.y; v[j].z += a.z; v[j].w += a.w;
        }
      }
#pragma unroll
      for (int j = 0; j < 4; ++j) *(float4*)((float*)hr + j * 256 + lane * 4) = v[j];
    }
  };
  auto finish_row = [&](int m, const float4 (&v)[4]) {
    const int r = modrow(m);
    const float* sh = modvec(P, l, r, which0);
    const float* scl = modvec(P, l, r, which0 + 1);
    float ss = 0.f;
#pragma unroll
    for (int j = 0; j < 4; ++j) ss += v[j].x * v[j].x + v[j].y * v[j].y + v[j].z * v[j].z + v[j].w * v[j].w;
    ss = wave_sum(ss);
    float rstd = rsqrtf(ss * (1.f / 1024.f) + 1e-6f);
#pragma unroll
    for (int j = 0; j < 4; ++j) {
      int c = j * 256 + lane * 4;
      float4 gg = *(const float4*)(g + c);
      float4 s4 = *(const float4*)(sh + c);
      float4 c4 = *(const float4*)(scl + c);
      float o0 = v[j].x * rstd * gg.x * (1.f + c4.x) + s4.x;
      float o1 = v[j].y * rstd * gg.y * (1.f + c4.y) + s4.y;
      float o2 = v[j].z * rstd * gg.z * (1.f + c4.z) + s4.z;
      float o3 = v[j].w * rstd * gg.w * (1.f + c4.w) + s4.w;
      *(uint2*)(A + (size_t)m * DM + c) = make_uint2(pk2(o0, o1), pk2(o2, o3));
    }
  };
#pragma unroll 1
  for (int m = vbid() * 4 + w; m < MROWS; m += 2 * nw) {
    const int m2 = m + nw;
    float4 va[4], vb[4];
    load_row(m, va);
    if (m2 < MROWS) load_row(m2, vb);
    finish_row(m, va);
    if (m2 < MROWS) finish_row(m2, vb);
  }
}

DEVI void phase_final(const Params& P) {
  const int tid = otid(), w = tid >> 6, lane = tid & 63;
  const float* g = P.in[I_GF];
  const int nw = nvb() * 4;
  auto load_row = [&](int m, float4 (&v)[4]) {
    const float* hr = P.out + (size_t)m * DM;
#pragma unroll
    for (int j = 0; j < 4; ++j) v[j] = *(const float4*)(hr + j * 256 + lane * 4);
  };
  auto finish_row = [&](int m, const float4 (&v)[4]) {
    float* hr = P.out + (size_t)m * DM;
    float ss = 0.f;
#pragma unroll
    for (int j = 0; j < 4; ++j) ss += v[j].x * v[j].x + v[j].y * v[j].y + v[j].z * v[j].z + v[j].w * v[j].w;
    ss = wave_sum(ss);
    float rstd = rsqrtf(ss * (1.f / 1024.f) + 1e-6f);
#pragma unroll
    for (int j = 0; j < 4; ++j) {
      int c = j * 256 + lane * 4;
      float4 gg = *(const float4*)(g + c);
      float4 o = make_float4(v[j].x * rstd * gg.x, v[j].y * rstd * gg.y, v[j].z * rstd * gg.z, v[j].w * rstd * gg.w);
      *(float4*)(hr + c) = o;
    }
  };
#pragma unroll 1
  for (int m = vbid() * 4 + w; m < 2 * SEQ; m += 2 * nw) {
    const int m2 = m + nw;
    float4 va[4], vb[4];
    load_row(m, va);
    if (m2 < 2 * SEQ) load_row(m2, vb);
    finish_row(m, va);
    if (m2 < 2 * SEQ) finish_row(m2, vb);
  }
}

constexpr int LDT = 72;
DEVI float sumsq8(bf16x8 v) {
  uint4 u = __builtin_bit_cast(uint4, v);
  float a = bflo(u.x), b = bfhi(u.x), c = bflo(u.y), d = bfhi(u.y), e = bflo(u.z), f = bfhi(u.z), g = bflo(u.w), h = bfhi(u.w);
  return a * a + b * b + c * c + d * d + e * e + f * f + g * g + h * h;
}
template <bool ROWNORM = false, class Epi>
DEVI void gemm_tile(const bf16_t* __restrict__ A, int lda, const bf16_t* __restrict__ Bt, int ldb, int K, int m0, int n0, bf16_t* smem, Epi epi) {
  bf16_t* As = smem;
  bf16_t* Bs = smem + 2 * 128 * LDT;
  const int tid = otid(), lane = tid & 63, w = tid >> 6;
  const int wm = w & 1, wn = w >> 1;
  f32x4 acc[4][4];
#pragma unroll
  for (int i = 0; i < 4; ++i)
#pragma unroll
    for (int j = 0; j < 4; ++j) acc[i][j] = (f32x4){0.f, 0.f, 0.f, 0.f};
  const int lrow = tid >> 3, lkc = (tid & 7) * 8;
  const bf16_t* ag = A + (size_t)(m0 + lrow) * lda + lkc;
  const bf16_t* bg = Bt + (size_t)(n0 + lrow) * ldb + lkc;
  u32x4 ra[4], rb[4];
#pragma unroll
  for (int i = 0; i < 4; ++i) {
    ra[i] = *(const u32x4*)(ag + (size_t)(32 * i) * lda);
    rb[i] = *(const u32x4*)(bg + (size_t)(32 * i) * ldb);
  }
  const int nk = K / 64;
  const int fr = lane & 15, fq = (lane >> 4) * 8;
  float ssq[4] = {0.f, 0.f, 0.f, 0.f};
  for (int kt = 0; kt < nk; ++kt) {
    const int buf = kt & 1;
    bf16_t* as = As + buf * 128 * LDT;
    bf16_t* bs = Bs + buf * 128 * LDT;
#pragma unroll
    for (int i = 0; i < 4; ++i) {
      *(u32x4*)(as + (lrow + 32 * i) * LDT + lkc) = ra[i];
      *(u32x4*)(bs + (lrow + 32 * i) * LDT + lkc) = rb[i];
    }
    __syncthreads();
    if (kt + 1 < nk) {
#pragma unroll
      for (int i = 0; i < 4; ++i) {
        ra[i] = *(const u32x4*)(ag + (size_t)(32 * i) * lda + (kt + 1) * 64);
        rb[i] = *(const u32x4*)(bg + (size_t)(32 * i) * ldb + (kt + 1) * 64);
      }
    }
#pragma unroll
    for (int ks = 0; ks < 2; ++ks) {
      bf16x8 af[4], bfr[4];
#pragma unroll
      for (int i = 0; i < 4; ++i) {
        af[i] = *(const bf16x8*)(as + (wm * 64 + i * 16 + fr) * LDT + ks * 32 + fq);
        bfr[i] = *(const bf16x8*)(bs + (wn * 64 + i * 16 + fr) * LDT + ks * 32 + fq);
        if (ROWNORM) ssq[i] += sumsq8(af[i]);
      }
#pragma unroll
      for (int i = 0; i < 4; ++i)
#pragma unroll
        for (int j = 0; j < 4; ++j) acc[i][j] = mfma16(bfr[j], af[i], acc[i][j]);
    }
  }
  __syncthreads();
#pragma unroll
  for (int i = 0; i < 4; ++i)
#pragma unroll
    for (int j = 0; j < 4; ++j) {
      int m = m0 + wm * 64 + i * 16 + fr;
      int n = n0 + wn * 64 + j * 16 + (lane >> 4) * 4;
      if (ROWNORM) {
        float t = ssq[i]; t += __shfl_xor(t, 16); t += __shfl_xor(t, 32);
        epi(m, n, acc[i][j] * rsqrtf(t / (float)K + 1e-6f));
      } else epi(m, n, acc[i][j]);
    }
}

DEVI void phase_prep(const Params& P, int l, unsigned char* smem) {
  const int tid = otid(), w = tid >> 6, lane = tid & 63;
  bf16_t* Pm = (bf16_t*)(P.ws + OFF_P);
  const float2* rs_swa = (const float2*)(P.ws + OFF_ROPE);
  const float2* rs_mla = (const float2*)(P.ws + OFF_ROPE + 16384);
  const float* convw = P.in[I_CONVW] + (size_t)l * 5 * 768;
  const float* convb = P.in[I_CONVB] + (size_t)l * 768;
  const float* gq = P.in[I_GQ] + l * 256;
  const float* gkv = P.in[I_GKV] + l * 128;
  const int gthreads = nvb() * 256, gt0 = vbid() * 256 + tid;
  for (int idx = gt0; idx < MROWS * 24; idx += gthreads) {
    int row = idx / 24, rem = idx - row * 24;
    int b = row / TOK, t = row - b * TOK;
    if (t < LCTX) continue;
    int hs = rem >> 2, half = (rem >> 1) & 1, j = rem & 1;
    int li = t - LCTX;
    int pos = half ? (li & 63) : (li >> 6);
    const float4* cp = (const float4*)(rs_swa + pos * 16 + j * 8);
    float4 c01 = cp[0], c23 = cp[1], c45 = cp[2], c67 = cp[3];
    bf16_t* bp = Pm + (size_t)row * PP + (hs < 4 ? C_SWQ + hs * 64 : C_SWK + (hs - 4) * 64) + half * 32 + j * 8;
    uint4 x1 = *(const uint4*)bp, x2 = *(const uint4*)(bp + 16);
    uint4 y1, y2;
    y1.x = pk2(bflo(x1.x) * c01.x - bflo(x2.x) * c01.y, bfhi(x1.x) * c01.z - bfhi(x2.x) * c01.w);
    y2.x = pk2(bflo(x2.x) * c01.x + bflo(x1.x) * c01.y, bfhi(x2.x) * c01.z + bfhi(x1.x) * c01.w);
    y1.y = pk2(bflo(x1.y) * c23.x - bflo(x2.y) * c23.y, bfhi(x1.y) * c23.z - bfhi(x2.y) * c23.w);
    y2.y = pk2(bflo(x2.y) * c23.x + bflo(x1.y) * c23.y, bfhi(x2.y) * c23.z + bfhi(x1.y) * c23.w);
    y1.z = pk2(bflo(x1.z) * c45.x - bflo(x2.z) * c45.y, bfhi(x1.z) * c45.z - bfhi(x2.z) * c45.w);
    y2.z = pk2(bflo(x2.z) * c45.x + bflo(x1.z) * c45.y, bfhi(x2.z) * c45.z + bfhi(x1.z) * c45.w);
    y1.w = pk2(bflo(x1.w) * c67.x - bflo(x2.w) * c67.y, bfhi(x1.w) * c67.z - bfhi(x2.w) * c67.w);
    y2.w = pk2(bflo(x2.w) * c67.x + bflo(x1.w) * c67.y, bfhi(x2.w) * c67.z + bfhi(x1.w) * c67.w);
    *(uint4*)bp = y1;
    *(uint4*)(bp + 16) = y2;
  }
  {
    bf16_t* tv = (bf16_t*)smem;
    for (int u = vbid(); u < 264 * 6; u += nvb()) {
      const int tt = u / 6, ct = u - tt * 6;
      const int r0 = tt * 64;
      const int b = r0 / TOK, tb = r0 - b * TOK;
      const int col = ct < 4 ? C_NAV + ct * 64 : C_SWV + (ct - 4) * 64;
      for (int c = tid; c < 512; c += 256) {
        int rr = c >> 3, part = c & 7;
        *(uint4*)(tv + rr * 72 + part * 8) = *(const uint4*)(Pm + (size_t)(r0 + rr) * PP + col + part * 8);
      }
      __syncthreads();
      bf16_t* dstb = ct < 4 ? (bf16_t*)(P.ws + OFF_VTNA) + (size_t)(b * 256 + ct * 64) * TOK + tb
                            : (bf16_t*)(P.ws + OFF_VTSWA) + (size_t)(b * 128 + (ct - 4) * 64) * TOK + tb;
      for (int c = tid; c < 512; c += 256) {
        int chl = c >> 3, part = c & 7, g16 = part >> 1, hh = part & 1;
        const bf16_t* tp = tv + (g16 * 16 + 4 * hh) * 72 + chl;
        uint4 ov = make_uint4((unsigned)tp[0] | ((unsigned)tp[72] << 16), (unsigned)tp[2 * 72] | ((unsigned)tp[3 * 72] << 16),
                              (unsigned)tp[8 * 72] | ((unsigned)tp[9 * 72] << 16), (unsigned)tp[10 * 72] | ((unsigned)tp[11 * 72] << 16));
        *(uint4*)(dstb + (size_t)chl * TOK + g16 * 16 + hh * 8) = ov;
      }
      __syncthreads();
    }
  }
  {
    const int nw = nvb() * 4;
#pragma unroll 1
    for (int rowi = vbid() * 4 + w; rowi < MROWS; rowi += nw) {
      int b = rowi / TOK, t = rowi - b * TOK;
      if (t >= LCTX && lane < 16) {
        bf16_t* row = Pm + (size_t)rowi * PP;
        int half = lane >> 3, ii = lane & 7;
        int li = t - LCTX;
        int pos = half ? (li & 63) : (li >> 6);
        float2 cs = rs_mla[pos * 8 + ii];
        bf16_t* bp = row + C_MKR + half * 16 + ii;
        float x1 = bf2f(bp[0]), x2 = bf2f(bp[8]);
        bp[0] = f2bf(x1 * cs.x - x2 * cs.y);
        bp[8] = f2bf(x2 * cs.x + x1 * cs.y);
      }
    }
  }
  {
    bf16_t* XBC = (bf16_t*)(P.ws + OFF_XBC);
    bf16_t* XBCT = (bf16_t*)(P.ws + OFF_XBCT);
    bf16_t* tin = (bf16_t*)smem;
    bf16_t* tout = tin + 68 * 72;
    float* wl = (float*)(tout + 64 * 72);
    for (int u = vbid(); u < 264 * 12; u += nvb()) {
      const int tt = u / 12, ct = u - tt * 12;
      const int r0 = tt * 64, ch0 = ct * 64;
      const int b = r0 / TOK, tb = r0 - b * TOK;
      const bool isctx = tb < LCTX;
      const int seg_lo = isctx ? 0 : LCTX, seg_hi = isctx ? LCTX : TOK;
      for (int c = tid; c < 68 * 8; c += 256) {
        int rr = c >> 3, part = c & 7;
        int tk = tb - 2 + rr;
        uint4 v = make_uint4(0u, 0u, 0u, 0u);
        if (tk >= seg_lo && tk < seg_hi) v = *(const uint4*)(Pm + (size_t)(b * TOK + tk) * PP + C_SX + ch0 + part * 8);
        *(uint4*)(tin + rr * 72 + part * 8) = v;
      }
      for (int c = tid; c < 384; c += 256) wl[c] = c < 320 ? convw[(c >> 6) * 768 + ch0 + (c & 63)] : convb[ch0 + c - 320];
      __syncthreads();
      {
        const int tok = tid & 63, cg = tid >> 6;
        float acc[16];
#pragma unroll
        for (int c = 0; c < 16; ++c) acc[c] = 0.f;
#pragma unroll
        for (int k = 0; k < 5; ++k) {
          const uint4 a = *(const uint4*)(tin + (tok + k) * 72 + cg * 16);
          const uint4 a2 = *(const uint4*)(tin + (tok + k) * 72 + cg * 16 + 8);
          const float* wk = wl + k * 64 + cg * 16;
          acc[0] += bflo(a.x) * wk[0]; acc[1] += bfhi(a.x) * wk[1]; acc[2] += bflo(a.y) * wk[2]; acc[3] += bfhi(a.y) * wk[3];
          acc[4] += bflo(a.z) * wk[4]; acc[5] += bfhi(a.z) * wk[5]; acc[6] += bflo(a.w) * wk[6]; acc[7] += bfhi(a.w) * wk[7];
          acc[8] += bflo(a2.x) * wk[8]; acc[9] += bfhi(a2.x) * wk[9]; acc[10] += bflo(a2.y) * wk[10]; acc[11] += bfhi(a2.y) * wk[11];
          acc[12] += bflo(a2.z) * wk[12]; acc[13] += bfhi(a2.z) * wk[13]; acc[14] += bflo(a2.w) * wk[14]; acc[15] += bfhi(a2.w) * wk[15];
        }
        const float* bk = wl + 320 + cg * 16;
#pragma unroll
        for (int c = 0; c < 16; ++c) acc[c] = siluf(acc[c] + bk[c]);
        *(uint4*)(tout + tok * 72 + cg * 16) = make_uint4(pk2(acc[0], acc[1]), pk2(acc[2], acc[3]), pk2(acc[4], acc[5]), pk2(acc[6], acc[7]));
        *(uint4*)(tout + tok * 72 + cg * 16 + 8) = make_uint4(pk2(acc[8], acc[9]), pk2(acc[10], acc[11]), pk2(acc[12], acc[13]), pk2(acc[14], acc[15]));
      }
      __syncthreads();
      for (int c = tid; c < 512; c += 256) {
        int rr = c >> 3, part = c & 7;
        *(uint4*)(XBC + (size_t)(r0 + rr) * 768 + ch0 + part * 8) = *(const uint4*)(tout + rr * 72 + part * 8);
      }
      if (ch0 < 512) {
        for (int c = tid; c < 512; c += 256) {
          int chl = c >> 3, part = c & 7;
          const bf16_t* tp = tout + (part * 8) * 72 + chl;
          uint4 ov = make_uint4((unsigned)tp[0] | ((unsigned)tp[72] << 16), (unsigned)tp[2 * 72] | ((unsigned)tp[3 * 72] << 16),
                                (unsigned)tp[4 * 72] | ((unsigned)tp[5 * 72] << 16), (unsigned)tp[6 * 72] | ((unsigned)tp[7 * 72] << 16));
          *(uint4*)(XBCT + (size_t)(b * 512 + ch0 + chl) * TOK + tb + part * 8) = ov;
        }
      }
      __syncthreads();
    }
  }
}

template <int MODE>
DEVI void flash_unit(const Params& P, int l, int b, int h, int qctx, int qi0) {
  const int lane = otid() & 63, q = lane & 31, hi = lane >> 5;
  const bf16_t* Pb = (const bf16_t*)(P.ws + OFF_P) + (size_t)b * TOK * PP;
  const int qt = (qctx ? 0 : LCTX) + qi0 + q;
  const int li = qi0 + q;
  const bf16_t* K1;
  const bf16_t* Vt;
  int ocol;
  const float sc2 = 0.125f * LOG2E;
  bf16x8 qop[4];
  if (MODE == 0) {
    const bf16_t* qs = Pb + (size_t)qt * PP + C_NAQ + h * 64 + hi * 8;
#pragma unroll
    for (int s = 0; s < 4; ++s) qop[s] = ld8(qs + 16 * s);
    K1 = Pb + C_NAK + h * 64;
    Vt = (const bf16_t*)(P.ws + OFF_VTNA) + (size_t)(b * 256 + h * 64) * TOK;
    ocol = h * 64;
  } else {
    const bf16_t* qs = Pb + (size_t)qt * PP + C_SWQ + h * 64 + hi * 8;
#pragma unroll
    for (int s = 0; s < 4; ++s) qop[s] = ld8(qs + 16 * s);
    K1 = Pb + C_SWK + (h >> 1) * 64;
    Vt = (const bf16_t*)(P.ws + OFF_VTSWA) + (size_t)(b * 128 + (h >> 1) * 64) * TOK;
    ocol = 256 + h * 64;
  }
  float m = -1e30f, lsum = 0.f;
  if (MODE == 1) {
    m = P.in[I_SINK][l * 4 + h] * LOG2E;
    lsum = hi ? 0.f : 1.f;
  }
  f32x16 o0, o1;
#pragma unroll
  for (int i = 0; i < 16; ++i) { o0[i] = 0.f; o1[i] = 0.f; }
  const int nr = li >> 6, qc = li & 63;
  int rs = nr - 4; rs = rs < 0 ? 0 : (rs > 120 ? 120 : rs);
  int cs = qc - 8; cs = cs < 0 ? 0 : (cs > 48 ? 48 : cs);
  const float* rpb = P.in[I_RPB] + (size_t)(l * 4 + h) * 15 * 31;
  const int qb = qi0 >> 5;
  const int nlo = (4 - qb) > 0 ? (4 - qb) : 0;
  const int nhi = (260 - qb) < 9 ? (260 - qb) : 9;
  const int nblk = qctx ? 8 : (MODE == 0 ? 24 : 8 + nhi - nlo);
  auto kt0_of = [&](int blk) -> int {
    if (blk < 8) return blk * 32;
    if (MODE == 0) { int idx = blk - 8; return LCTX + (rs + (idx >> 1)) * 64 + (idx & 1) * 32; }
    return LCTX + qi0 - 128 + 32 * (nlo + blk - 8);
  };
  bf16x8 kc[4];
  {
    const bf16_t* kp = K1 + (size_t)(kt0_of(0) + q) * PP + hi * 8;
#pragma unroll
    for (int s = 0; s < 4; ++s) kc[s] = ld8(kp + 16 * s);
  }
#pragma unroll 1
  for (int blk = 0; blk < nblk; ++blk) {
    const int kt0 = kt0_of(blk);
    const bf16_t* vp = Vt + (size_t)q * TOK + kt0 + 8 * hi;
    bf16x8 v00 = ld8(vp), v01 = ld8(vp + 16), v10 = ld8(vp + (size_t)32 * TOK), v11 = ld8(vp + (size_t)32 * TOK + 16);
    bf16x8 kn[4];
    {
      const int nb = (blk + 1 < nblk) ? blk + 1 : blk;
      const bf16_t* kp = K1 + (size_t)(kt0_of(nb) + q) * PP + hi * 8;
#pragma unroll
      for (int s = 0; s < 4; ++s) kn[s] = ld8(kp + 16 * s);
    }
    f32x16 st;
#pragma unroll
    for (int i = 0; i < 16; ++i) st[i] = 0.f;
#pragma unroll
    for (int s = 0; s < 4; ++s) st = mfma32(kc[s], qop[s], st);
    float sc[16];
#pragma unroll
    for (int i = 0; i < 16; ++i) sc[i] = st[i] * sc2;
    if (blk >= 8) {
      if (MODE == 0) {
        const int idx = blk - 8, kr = rs + (idx >> 1), cb = idx & 1;
        const float* rp = rpb + (kr - nr + 7) * 31;
#pragma unroll
        for (int i = 0; i < 16; ++i) {
          int kcol = cb * 32 + 8 * (i >> 2) + 4 * hi + (i & 3);
          int dc = kcol - qc + 15; dc = dc < 0 ? 0 : (dc > 30 ? 30 : dc);
          bool valid = (kcol >= cs) && (kcol < cs + 16);
          sc[i] = valid ? sc[i] + rp[dc] * LOG2E : -INFINITY;
        }
      } else {
        const int js = kt0 - LCTX;
#pragma unroll
        for (int i = 0; i < 16; ++i) {
          int j = js + 8 * (i >> 2) + 4 * hi + (i & 3);
          int d = li - j; d = d < 0 ? -d : d;
          sc[i] = (d <= 128) ? sc[i] : -INFINITY;
        }
      }
    }
    float mx = sc[0];
#pragma unroll
    for (int i = 1; i < 16; ++i) mx = fmaxf(mx, sc[i]);
    mx = fmaxf(mx, __shfl_xor(mx, 32));
    float mn = fmaxf(m, mx);
    float alpha = ex2(m - mn);
    m = mn;
    float ps = 0.f;
#pragma unroll
    for (int i = 0; i < 16; ++i) { sc[i] = ex2(sc[i] - mn); ps += sc[i]; }
    lsum = lsum * alpha + ps;
#pragma unroll
    for (int i = 0; i < 16; ++i) { o0[i] *= alpha; o1[i] *= alpha; }
    bf16x8 p0 = mk8(pk2(sc[0], sc[1]), pk2(sc[2], sc[3]), pk2(sc[4], sc[5]), pk2(sc[6], sc[7]));
    bf16x8 p1 = mk8(pk2(sc[8], sc[9]), pk2(sc[10], sc[11]), pk2(sc[12], sc[13]), pk2(sc[14], sc[15]));
    o0 = mfma32(v00, p0, o0);
    o0 = mfma32(v01, p1, o0);
    o1 = mfma32(v10, p0, o1);
    o1 = mfma32(v11, p1, o1);
#pragma unroll
    for (int s = 0; s < 4; ++s) kc[s] = kn[s];
  }
  float lt = lsum + __shfl_xor(lsum, 32);
  float inv = 1.f / lt;
  bf16_t* op = (bf16_t*)(P.ws + OFF_A) + (size_t)(b * TOK + qt) * DM + ocol + 4 * hi;
#pragma unroll
  for (int i4 = 0; i4 < 4; ++i4) {
    *(uint2*)(op + 8 * i4) = make_uint2(pk2(o0[4 * i4] * inv, o0[4 * i4 + 1] * inv), pk2(o0[4 * i4 + 2] * inv, o0[4 * i4 + 3] * inv));
    *(uint2*)(op + 32 + 8 * i4) = make_uint2(pk2(o1[4 * i4] * inv, o1[4 * i4 + 1] * inv), pk2(o1[4 * i4 + 2] * inv, o1[4 * i4 + 3] * inv));
  }
}

typedef __attribute__((address_space(3))) unsigned lds_u32;
struct HalfBar { lds_u32* cnt; unsigned tgt; };
DEVI void half_barrier(HalfBar& hb) {
  hb.tgt += 4u;
  asm volatile("s_waitcnt lgkmcnt(0)" ::: "memory");
  if ((threadIdx.x & 63) == 0) __hip_atomic_fetch_add(hb.cnt, 1u, __ATOMIC_RELEASE, __HIP_MEMORY_SCOPE_WORKGROUP);
  while (__hip_atomic_load(hb.cnt, __ATOMIC_ACQUIRE, __HIP_MEMORY_SCOPE_WORKGROUP) < hb.tgt) __builtin_amdgcn_s_sleep(1);
  asm volatile("" ::: "memory");
}

constexpr int KLD = 104, VLD = 72;
DEVI void mla_block(const Params& P, int l, int b, int h, int qctx, int qb0, unsigned char* smem, HalfBar& hb) {
  const int tid = otid(), lane = tid & 63, w = tid >> 6, q = lane & 31, hi = lane >> 5;
  bf16_t* Kl = (bf16_t*)smem;
  const int qi0 = qb0 + w * 32;
  const int qt = (qctx ? 0 : LCTX) + qi0 + q;
  const int li = qi0 + q;
  const float sc2 = 0.10206207261596577f * LOG2E;
  bf16x8 qop[6];
  {
    const bf16_t* qs = (const bf16_t*)(P.ws + OFF_MQ) + (size_t)(b * TOK + qt) * 384 + h * 96 + hi * 8;
    const float2* rs_mla = (const float2*)(P.ws + OFF_ROPE + 16384);
#pragma unroll
    for (int s = 0; s < 6; ++s) {
      uint4 own = *(const uint4*)(qs + 16 * s);
      float f0 = bflo(own.x), f1 = bfhi(own.x), f2 = bflo(own.y), f3 = bfhi(own.y), f4 = bflo(own.z), f5 = bfhi(own.z), f6 = bflo(own.w), f7 = bfhi(own.w);
      if (s >= 4 && !qctx) {
        int pos = (s == 4) ? (li >> 6) : (li & 63);
        uint4 oth;
        oth.x = __shfl_xor((int)own.x, 32); oth.y = __shfl_xor((int)own.y, 32);
        oth.z = __shfl_xor((int)own.z, 32); oth.w = __shfl_xor((int)own.w, 32);
        float sg = hi ? 1.f : -1.f;
        const float2* cp = rs_mla + pos * 8;
        float2 c0 = cp[0], c1 = cp[1], c2 = cp[2], c3 = cp[3], c4 = cp[4], c5 = cp[5], c6 = cp[6], c7 = cp[7];
        f0 = f0 * c0.x + sg * bflo(oth.x) * c0.y; f1 = f1 * c1.x + sg * bfhi(oth.x) * c1.y;
        f2 = f2 * c2.x + sg * bflo(oth.y) * c2.y; f3 = f3 * c3.x + sg * bfhi(oth.y) * c3.y;
        f4 = f4 * c4.x + sg * bflo(oth.z) * c4.y; f5 = f5 * c5.x + sg * bfhi(oth.z) * c5.y;
        f6 = f6 * c6.x + sg * bflo(oth.w) * c6.y; f7 = f7 * c7.x + sg * bfhi(oth.w) * c7.y;
      }
      qop[s] = mk8(pk2(f0 * sc2, f1 * sc2), pk2(f2 * sc2, f3 * sc2), pk2(f4 * sc2, f5 * sc2), pk2(f6 * sc2, f7 * sc2));
    }
  }
  const bf16_t* MKb = (const bf16_t*)(P.ws + OFF_MK) + (size_t)b * TOK * 256 + h * 64;
  const bf16_t* KRb = (const bf16_t*)(P.ws + OFF_P) + (size_t)b * TOK * PP + C_MKR;
  const bf16_t* VTb = (const bf16_t*)(P.ws + OFF_VTMLA) + (size_t)(b * 256 + h * 64) * TOK;
  const int nt = qctx ? 4 : 132;
  const int kk = tid >> 3, kpart = (tid & 7) * 8;
  const int rk = tid >> 2, rpart = (tid & 3) * 8;
  constexpr int BUFE = 64 * (KLD + VLD);
  u32x4 gk0, gk1, gr, gv0, gv1;
  auto gload = [&](int t) {
    const int kt0 = t * 64;
    gk0 = *(const u32x4*)(MKb + (size_t)(kt0 + kk) * 256 + kpart);
    gk1 = *(const u32x4*)(MKb + (size_t)(kt0 + kk + 32) * 256 + kpart);
    gr = *(const u32x4*)(KRb + (size_t)(kt0 + rk) * PP + rpart);
    gv0 = *(const u32x4*)(VTb + (size_t)kk * TOK + kt0 + kpart);
    gv1 = *(const u32x4*)(VTb + (size_t)(kk + 32) * TOK + kt0 + kpart);
  };
  auto lstore = [&](int buf) {
    bf16_t* kl = Kl + buf * BUFE;
    bf16_t* vl = kl + 64 * KLD;
    *(u32x4*)(kl + kk * KLD + kpart) = gk0;
    *(u32x4*)(kl + (kk + 32) * KLD + kpart) = gk1;
    *(u32x4*)(kl + rk * KLD + 64 + rpart) = gr;
    *(u32x4*)(vl + kk * VLD + kpart) = gv0;
    *(u32x4*)(vl + (kk + 32) * VLD + kpart) = gv1;
  };
  float m = 0.f, lsum = 0.f;
  f32x16 o0, o1, sA0, sA1, sB0, sB1;
#pragma unroll
  for (int i = 0; i < 16; ++i) { o0[i] = 0.f; o1[i] = 0.f; }
  auto step = [&](bool PREV, bool CUR, bool first, int bc, int bp, f32x16& p0, f32x16& p1, f32x16& c0, f32x16& c1) {
    bf16x8 kx[6], va[4], vb[4];
    const bf16_t* kl = Kl + bc * BUFE + q * KLD + hi * 8;
    if (CUR) {
#pragma unroll
      for (int s = 0; s < 6; ++s) kx[s] = *(const bf16x8*)(kl + 16 * s);
    }
    if (PREV) {
      float mx = max3f(p0[0], p1[0], p0[1]);
      mx = max3f(mx, p1[1], p0[2]); mx = max3f(mx, p1[2], p0[3]); mx = max3f(mx, p1[3], p0[4]); mx = max3f(mx, p1[4], p0[5]);
      mx = max3f(mx, p1[5], p0[6]); mx = max3f(mx, p1[6], p0[7]); mx = max3f(mx, p1[7], p0[8]); mx = max3f(mx, p1[8], p0[9]);
      mx = max3f(mx, p1[9], p0[10]); mx = max3f(mx, p1[10], p0[11]); mx = max3f(mx, p1[11], p0[12]); mx = max3f(mx, p1[12], p0[13]);
      mx = max3f(mx, p1[13], p0[14]); mx = max3f(mx, p1[14], p0[15]); mx = max3f(mx, p1[15], mx);
      if (__any(mx > 8.f) || first) {
        mx = fmaxf(mx, __shfl_xor(mx, 32));
        float d = first ? mx : fmaxf(mx, 0.f);
        m += d;
        float alpha = ex2(-d);
        lsum *= alpha;
#pragma unroll
        for (int i = 0; i < 16; ++i) { o0[i] *= alpha; o1[i] *= alpha; p0[i] -= d; p1[i] -= d; }
      }
    }
    float ps = 0.f;
    if (CUR) {
      const float negm = -m;
#pragma unroll
      for (int i = 0; i < 16; ++i) c0[i] = negm;
#pragma unroll
      for (int s = 0; s < 6; ++s) c0 = mfma32(kx[s], qop[s], c0);
    }
    if (PREV) {
#pragma unroll
      for (int i = 0; i < 16; ++i) { p0[i] = ex2(p0[i]); ps += p0[i]; }
    }
    __builtin_amdgcn_sched_barrier(0);
    if (CUR) {
#pragma unroll
      for (int s = 0; s < 6; ++s) kx[s] = *(const bf16x8*)(kl + 32 * KLD + 16 * s);
      const float negm = -m;
#pragma unroll
      for (int i = 0; i < 16; ++i) c1[i] = negm;
#pragma unroll
      for (int s = 0; s < 6; ++s) c1 = mfma32(kx[s], qop[s], c1);
    }
    if (PREV) {
      const bf16_t* vl = Kl + bp * BUFE + 64 * KLD + q * VLD + hi * 8;
#pragma unroll
      for (int s = 0; s < 4; ++s) { va[s] = *(const bf16x8*)(vl + 16 * s); vb[s] = *(const bf16x8*)(vl + 32 * VLD + 16 * s); }
#pragma unroll
      for (int i = 0; i < 16; ++i) { p1[i] = ex2(p1[i]); ps += p1[i]; }
      lsum += ps;
      bf16x8 pa0 = mk8(pk2(p0[0], p0[1]), pk2(p0[2], p0[3]), pk2(p0[4], p0[5]), pk2(p0[6], p0[7]));
      bf16x8 pa1 = mk8(pk2(p0[8], p0[9]), pk2(p0[10], p0[11]), pk2(p0[12], p0[13]), pk2(p0[14], p0[15]));
      bf16x8 pb0 = mk8(pk2(p1[0], p1[1]), pk2(p1[2], p1[3]), pk2(p1[4], p1[5]), pk2(p1[6], p1[7]));
      bf16x8 pb1 = mk8(pk2(p1[8], p1[9]), pk2(p1[10], p1[11]), pk2(p1[12], p1[13]), pk2(p1[14], p1[15]));
      o0 = mfma32(va[0], pa0, o0);
      o1 = mfma32(vb[0], pa0, o1);
      o0 = mfma32(va[1], pa1, o0);
      o1 = mfma32(vb[1], pa1, o1);
      o0 = mfma32(va[2], pb0, o0);
      o1 = mfma32(vb[2], pb0, o1);
      o0 = mfma32(va[3], pb1, o0);
      o1 = mfma32(vb[3], pb1, o1);
    }
  };
  __builtin_amdgcn_s_setprio(1);
  half_barrier(hb);
  gload(0);
  lstore(0);
  half_barrier(hb);
  gload(1);
  step(false, true, false, 0, 0, sA0, sA1, sA0, sA1);
  lstore(1);
  half_barrier(hb);
  int bp = 0, bc = 1;
  int t = 1;
#pragma unroll 1
  for (; t + 1 < nt; t += 2) {
    {
      const int bn = bc == 2 ? 0 : bc + 1;
      gload(t + 1);
      step(true, true, t == 1, bc, bp, sA0, sA1, sB0, sB1);
      lstore(bn);
      bp = bc; bc = bn;
      half_barrier(hb);
    }
    {
      const int bn = bc == 2 ? 0 : bc + 1;
      if (t + 2 < nt) gload(t + 2);
      step(true, true, false, bc, bp, sB0, sB1, sA0, sA1);
      if (t + 2 < nt) lstore(bn);
      bp = bc; bc = bn;
      half_barrier(hb);
    }
  }
  step(true, true, false, bc, bp, sA0, sA1, sB0, sB1);
  step(true, false, false, bc, bc, sB0, sB1, sB0, sB1);
  __builtin_amdgcn_s_setprio(0);
  float lt = lsum + __shfl_xor(lsum, 32);
  float inv = 1.f / lt;
  bf16_t* op = (bf16_t*)(P.ws + OFF_A) + (size_t)(b * TOK + qt) * DM + 512 + h * 64 + 4 * hi;
#pragma unroll
  for (int i4 = 0; i4 < 4; ++i4) {
    *(uint2*)(op + 8 * i4) = make_uint2(pk2(o0[4 * i4] * inv, o0[4 * i4 + 1] * inv), pk2(o0[4 * i4 + 2] * inv, o0[4 * i4 + 3] * inv));
    *(uint2*)(op + 32 + 8 * i4) = make_uint2(pk2(o1[4 * i4] * inv, o1[4 * i4 + 1] * inv), pk2(o1[4 * i4 + 2] * inv, o1[4 * i4 + 3] * inv));
  }
}

DEVI void ssd_s1_unit(const Params& P, int l, int cgk, int h, float* smem, HalfBar& hb) {
  const int tid = otid(), w = tid >> 6, lane = tid & 63, q = lane & 31, hi = lane >> 5;
  const int b = cgk / 66, c = cgk - b * 66;
  const int t0 = c * 128, r0 = cgk * 128;
  const int g = h >> 1;
  float* wj = smem;
  const bf16_t* Pm = (const bf16_t*)(P.ws + OFF_P);
  if (w < 2) {
    const int dir = w;
    const float bias = P.in[I_DTB][l * 8 + dir * 4 + h];
    const float a = -__expf(P.in[I_ALOG][l * 8 + dir * 4 + h]);
    float raw0 = bf2f(Pm[(size_t)(r0 + 2 * lane) * PP + C_SDT + dir * 4 + h]) + bias;
    float raw1 = bf2f(Pm[(size_t)(r0 + 2 * lane + 1) * PP + C_SDT + dir * 4 + h]) + bias;
    float dt0 = softplusf(raw0);
    float dt1 = softplusf(raw1);
    float v0 = dt0 * a, v1 = dt1 * a;
    float s = v0 + v1;
    float inc = s;
#pragma unroll
    for (int o = 1; o < 64; o <<= 1) {
      float t = __shfl_up(inc, o);
      if (lane >= o) inc += t;
    }
    float T = __int_as_float(__builtin_amdgcn_readlane(__float_as_int(inc), 63));
    float exc = inc - s;
    float L0, L1;
    if (dir == 0) { L0 = exc + v0; L1 = exc + s; }
    else { L0 = T - exc; L1 = T - exc - v0; }
    float* DT = (float*)(P.ws + OFF_DT);
    float* LL = (float*)(P.ws + OFF_L);
    DT[(size_t)(r0 + 2 * lane) * 8 + dir * 4 + h] = dt0;
    DT[(size_t)(r0 + 2 * lane + 1) * 8 + dir * 4 + h] = dt1;
    LL[(size_t)(r0 + 2 * lane) * 8 + dir * 4 + h] = L0;
    LL[(size_t)(r0 + 2 * lane + 1) * 8 + dir * 4 + h] = L1;
    wj[dir * 128 + 2 * lane] = dt0 * __expf(T - L0);
    wj[dir * 128 + 2 * lane + 1] = dt1 * __expf(T - L1);
    if (lane == 0) ((float*)(P.ws + OFF_CD))[cgk * 8 + dir * 4 + h] = __expf(T);
  }
  half_barrier(hb);
  const bf16_t* XT = (const bf16_t*)(P.ws + OFF_XBCT) + (size_t)b * 512 * TOK + t0;
  const bf16_t* xr0 = XT + (size_t)(h * 64 + q) * TOK + hi * 8;
  const bf16_t* xr1 = xr0 + (size_t)32 * TOK;
  const bf16_t* br = XT + (size_t)(256 + g * 128 + w * 32 + q) * TOK + hi * 8;
  f32x16 acc[2][2];
#pragma unroll
  for (int d = 0; d < 2; ++d)
#pragma unroll
    for (int mt = 0; mt < 2; ++mt)
#pragma unroll
      for (int i = 0; i < 16; ++i) acc[d][mt][i] = 0.f;
#pragma unroll 2
  for (int ks = 0; ks < 8; ++ks) {
    bf16x8 bop = ld8(br + 16 * ks);
    uint4 x0 = *(const uint4*)(xr0 + 16 * ks);
    uint4 x1 = *(const uint4*)(xr1 + 16 * ks);
#pragma unroll
    for (int d = 0; d < 2; ++d) {
      const float* wp = wj + d * 128 + 16 * ks + hi * 8;
      float4 wa = *(const float4*)wp, wb = *(const float4*)(wp + 4);
      bf16x8 a0 = mk8(pk2(bflo(x0.x) * wa.x, bfhi(x0.x) * wa.y), pk2(bflo(x0.y) * wa.z, bfhi(x0.y) * wa.w),
                      pk2(bflo(x0.z) * wb.x, bfhi(x0.z) * wb.y), pk2(bflo(x0.w) * wb.z, bfhi(x0.w) * wb.w));
      bf16x8 a1 = mk8(pk2(bflo(x1.x) * wa.x, bfhi(x1.x) * wa.y), pk2(bflo(x1.y) * wa.z, bfhi(x1.y) * wa.w),
                      pk2(bflo(x1.z) * wb.x, bfhi(x1.z) * wb.y), pk2(bflo(x1.w) * wb.z, bfhi(x1.w) * wb.w));
      acc[d][0] = mfma32(a0, bop, acc[d][0]);
      acc[d][1] = mfma32(a1, bop, acc[d][1]);
    }
  }
  float* ST = (float*)(P.ws + OFF_ST);
#pragma unroll
  for (int d = 0; d < 2; ++d)
#pragma unroll
    for (int mt = 0; mt < 2; ++mt)
#pragma unroll
      for (int i = 0; i < 16; ++i) {
        int p = mt * 32 + 8 * (i >> 2) + 4 * hi + (i & 3);
        ST[((size_t)(cgk * 2 + d) * 4 + h) * 8192 + p * 128 + w * 32 + q] = acc[d][mt][i];
      }
  half_barrier(hb);
}

DEVI void phase_ssd_scan(const Params& P) {
  const float* ST = (const float*)(P.ws + OFF_ST);
  const float* CD = (const float*)(P.ws + OFF_CD);
  bf16_t* HS = (bf16_t*)(P.ws + OFF_HS);
  const int tid = otid();
  for (int idx = vbid() * 256 + tid; idx < 2 * 2 * 4 * 8192; idx += nvb() * 256) {
    int e = idx & 8191, h = (idx >> 13) & 3, dir = (idx >> 15) & 1, b = idx >> 16;
    float state = 0.f;
#pragma unroll 22
    for (int step = 0; step < 66; ++step) {
      int c = dir == 0 ? step : (step == 0 ? 1 : (step == 1 ? 0 : 67 - step));
      int cgk = b * 66 + c;
      size_t off = ((size_t)(cgk * 2 + dir) * 4 + h) * 8192 + e;
      HS[off] = f2bf(state);
      state = state * CD[cgk * 8 + dir * 4 + h] + ST[off];
    }
  }
}

DEVI void ssd_s3_unit(const Params& P, int l, int cgk, int qb, float* smem) {
  const int tid = otid(), h = tid >> 6, lane = tid & 63, q = lane & 31, hi = lane >> 5;
  const int b = cgk / 66, c = cgk - b * 66;
  const int t0 = c * 128, r0 = cgk * 128;
  const int g = h >> 1;
  float4* tab = (float4*)smem;
  float* red = smem + 4 * 128 * 4;
  const float* DT = (const float*)(P.ws + OFF_DT);
  const float* LL = (const float*)(P.ws + OFF_L);
  for (int i = tid; i < 512; i += 256) {
    int hh = i >> 7, j = i & 127;
    size_t o = (size_t)(r0 + j) * 8;
    tab[i] = make_float4(LL[o + hh], LL[o + 4 + hh], DT[o + hh], DT[o + 4 + hh]);
  }
  __syncthreads();
  const int ti = qb * 32 + q;
  const bf16_t* XBC = (const bf16_t*)(P.ws + OFF_XBC);
  const bf16_t* crow = XBC + (size_t)(r0 + ti) * 768 + 512 + g * 128 + hi * 8;
  bf16x8 qop[8];
#pragma unroll
  for (int s = 0; s < 8; ++s) qop[s] = ld8(crow + 16 * s);
  const float4 me = tab[h * 128 + ti];
  const float Li0 = me.x, Li1 = me.y;
  f32x16 o0, o1;
#pragma unroll
  for (int i = 0; i < 16; ++i) { o0[i] = 0.f; o1[i] = 0.f; }
  const bf16_t* XT = (const bf16_t*)(P.ws + OFF_XBCT) + (size_t)b * 512 * TOK + t0;
#pragma unroll 1
  for (int jb = 0; jb < 4; ++jb) {
    f32x16 st;
#pragma unroll
    for (int i = 0; i < 16; ++i) st[i] = 0.f;
    const bf16_t* brow = XBC + (size_t)(r0 + jb * 32 + q) * 768 + 256 + g * 128 + hi * 8;
#pragma unroll
    for (int s = 0; s < 8; ++s) st = mfma32(ld8(brow + 16 * s), qop[s], st);
    float wv[16];
#pragma unroll
    for (int i = 0; i < 16; ++i) {
      int j = jb * 32 + 8 * (i >> 2) + 4 * hi + (i & 3);
      float4 tj = tab[h * 128 + j];
      float wgt = 0.f;
      if (j <= ti) wgt += tj.z * __expf(fminf(Li0 - tj.x, 0.f));
      if (j >= ti) wgt += tj.w * __expf(fminf(Li1 - tj.y, 0.f));
      wv[i] = st[i] * wgt;
    }
    bf16x8 p0 = mk8(pk2(wv[0], wv[1]), pk2(wv[2], wv[3]), pk2(wv[4], wv[5]), pk2(wv[6], wv[7]));
    bf16x8 p1 = mk8(pk2(wv[8], wv[9]), pk2(wv[10], wv[11]), pk2(wv[12], wv[13]), pk2(wv[14], wv[15]));
    const bf16_t* vp = XT + (size_t)(h * 64 + q) * TOK + jb * 32 + 4 * hi;
    const bf16_t* vp1 = vp + (size_t)32 * TOK;
    o0 = mfma32(ld4x2(vp, vp + 8), p0, o0);
    o0 = mfma32(ld4x2(vp + 16, vp + 24), p1, o0);
    o1 = mfma32(ld4x2(vp1, vp1 + 8), p0, o1);
    o1 = mfma32(ld4x2(vp1 + 16, vp1 + 24), p1, o1);
  }
  const bf16_t* HS = (const bf16_t*)(P.ws + OFF_HS);
#pragma unroll 1
  for (int d = 0; d < 2; ++d) {
    const bf16_t* hp = HS + ((size_t)(cgk * 2 + d) * 4 + h) * 8192 + (size_t)q * 128 + hi * 8;
    f32x16 a0, a1;
#pragma unroll
    for (int i = 0; i < 16; ++i) { a0[i] = 0.f; a1[i] = 0.f; }
#pragma unroll
    for (int s = 0; s < 8; ++s) {
      a0 = mfma32(ld8(hp + 16 * s), qop[s], a0);
      a1 = mfma32(ld8(hp + 32 * 128 + 16 * s), qop[s], a1);
    }
    float e = __expf(d == 0 ? Li0 : Li1);
#pragma unroll
    for (int i = 0; i < 16; ++i) { o0[i] += e * a0[i]; o1[i] += e * a1[i]; }
  }
  const float dsk = P.in[I_SSDD][l * 4 + h];
  const bf16_t* xrow = XBC + (size_t)(r0 + ti) * 768 + h * 64 + 4 * hi;
  const bf16_t* zrow = (const bf16_t*)(P.ws + OFF_P) + (size_t)(r0 + ti) * PP + C_SZ + h * 64 + 4 * hi;
  float ssq = 0.f;
#pragma unroll
  for (int i4 = 0; i4 < 4; ++i4) {
    uint2 xa = *(const uint2*)(xrow + 8 * i4), xb = *(const uint2*)(xrow + 32 + 8 * i4);
    uint2 za = *(const uint2*)(zrow + 8 * i4), zb = *(const uint2*)(zrow + 32 + 8 * i4);
    float xs0[4] = {bflo(xa.x), bfhi(xa.x), bflo(xa.y), bfhi(xa.y)};
    float xs1[4] = {bflo(xb.x), bfhi(xb.x), bflo(xb.y), bfhi(xb.y)};
    float zs0[4] = {bflo(za.x), bfhi(za.x), bflo(za.y), bfhi(za.y)};
    float zs1[4] = {bflo(zb.x), bfhi(zb.x), bflo(zb.y), bfhi(zb.y)};
#pragma unroll
    for (int k = 0; k < 4; ++k) {
      float y0 = (o0[4 * i4 + k] + dsk * xs0[k]) * siluf(zs0[k]);
      float y1 = (o1[4 * i4 + k] + dsk * xs1[k]) * siluf(zs1[k]);
      o0[4 * i4 + k] = y0; o1[4 * i4 + k] = y1;
      ssq += y0 * y0 + y1 * y1;
    }
  }
  ssq += __shfl_xor(ssq, 32);
  if (hi == 0) red[h * 32 + q] = ssq;
  __syncthreads();
  float tot = red[q] + red[32 + q] + red[64 + q] + red[96 + q];
  float rstd = rsqrtf(tot * (1.f / 256.f) + 1e-6f);
  const float* gn = P.in[I_SSDG] + l * 256 + h * 64 + 4 * hi;
  bf16_t* op = (bf16_t*)(P.ws + OFF_A) + (size_t)(r0 + ti) * DM + 768 + h * 64 + 4 * hi;
#pragma unroll
  for (int i4 = 0; i4 < 4; ++i4) {
    float4 ga = *(const float4*)(gn + 8 * i4), gb = *(const float4*)(gn + 32 + 8 * i4);
    *(uint2*)(op + 8 * i4) = make_uint2(pk2(o0[4 * i4] * rstd * ga.x, o0[4 * i4 + 1] * rstd * ga.y), pk2(o0[4 * i4 + 2] * rstd * ga.z, o0[4 * i4 + 3] * rstd * ga.w));
    *(uint2*)(op + 32 + 8 * i4) = make_uint2(pk2(o1[4 * i4] * rstd * gb.x, o1[4 * i4 + 1] * rstd * gb.y), pk2(o1[4 * i4 + 2] * rstd * gb.z, o1[4 * i4 + 3] * rstd * gb.w));
  }
  __syncthreads();
}

typedef __attribute__((address_space(3))) unsigned char lds_u8;
DEVI void phase_gemm_in(const Params& P, int l, lds_u8* lds) {
  pg8::Gemm g{(const bf16_t*)(P.ws + OFF_A), (const bf16_t*)(P.ws + OFF_WTIN) + (size_t)l * PP * 1024, MROWS, PP, 1024};
  pg8::MySched S; S.init(66, 11, (int)gridDim.x, (int)blockIdx.x, 0);
  pg8::EpiStore<0> E{(bf16_t*)(P.ws + OFF_P), PP};
  pg8::gemm_phase<pg8::EpiStore<0>, pg8::MySched, true, true>(lds, g, S, E);
}

DEVI void phase_mla_gemm(const Params& P, int l, bf16_t* smem) {
  const bf16_t* Pm = (const bf16_t*)(P.ws + OFF_P);
  const bf16_t* Wq = (const bf16_t*)(P.ws + OFF_WTUQ) + (size_t)l * 384 * 256;
  const bf16_t* Wkv = (const bf16_t*)(P.ws + OFF_WTUKV) + (size_t)l * 512 * 128;
  bf16_t* MQ = (bf16_t*)(P.ws + OFF_MQ);
  bf16_t* MK = (bf16_t*)(P.ws + OFF_MK);
  bf16_t* VT = (bf16_t*)(P.ws + OFF_VTMLA);
  for (int u = vbid(); u < 132 * 7; u += nvb()) {
    int tm, tn;
    if (u < 396) { tm = u / 3; tn = u - tm * 3; } else { int r = u - 396; tm = r >> 2; tn = 3 + (r & 3); }
    if (tn < 3) {
      gemm_tile<true>(Pm + C_MCQ, PP, Wq, 256, 256, tm * 128, tn * 128, smem, [&](int m, int n, f32x4 v) {
        *(uint2*)(MQ + (size_t)m * 384 + n) = make_uint2(pk2(v[0], v[1]), pk2(v[2], v[3]));
      });
    } else {
      int hh = tn - 3;
      gemm_tile<true>(Pm + C_MCKV, PP, Wkv, 128, 128, tm * 128, hh * 128, smem, [&](int m, int n, f32x4 v) {
        int cc = n - hh * 128;
        if (cc < 64) {
          *(uint2*)(MK + (size_t)m * 256 + hh * 64 + cc) = make_uint2(pk2(v[0], v[1]), pk2(v[2], v[3]));
        } else {
          int bb = m / TOK, t = m - bb * TOK;
          int tp = (t & ~15) | (8 * ((t >> 2) & 1) + 4 * ((t >> 3) & 1) + (t & 3));
          bf16_t* d = VT + (size_t)(bb * 256 + hh * 64 + cc - 64) * TOK + tp;
          d[0] = f2bf(v[0]); d[TOK] = f2bf(v[1]); d[2 * TOK] = f2bf(v[2]); d[3 * TOK] = f2bf(v[3]);
        }
      });
    }
  }
}

DEVI void phase_mix(const Params& P, int l, float* smem, lds_u32* hbcnt) {
  const int w = otid() >> 6;
  if (otid() == 0) *hbcnt = 0u;
  __syncthreads();
  HalfBar hb{hbcnt, 0u};
  const int vb = vbid(), half = vb & 1;
#pragma unroll 1
  for (int jj = 0; jj < 5; ++jj) {
    const int j = half ? (jj == 4 ? 0 : jj + 1) : jj;
    const int u = vb + j * nvb();
    if (u >= 2112) continue;
    const bool small = u >= 2048;
    if (small && l == NLAYER - 1 && u < 2096) continue;
    const int kind = small ? ((u - 2048) >> 4) : (u >> 9);
    const int r = small ? ((u - 2048) & 15) : (u & 511);
    if (kind == 0) {
      const int bh = (r >> 1) & 7, qi = ((r >> 4) << 1) | (r & 1);
      mla_block(P, l, bh >> 2, bh & 3, small ? 1 : 0, qi * 128, (unsigned char*)smem, hb);
    } else if (kind == 3) {
      const int cc = r >> 2;
      const int cgk = small ? ((cc >> 1) * 66 + (cc & 1)) : ((cc >> 6) * 66 + 2 + (cc & 63));
      ssd_s1_unit(P, l, cgk, r & 3, smem, hb);
    } else {
      const int rr = small ? r : ((((r >> 1) & 7) << 6) | ((r >> 4) << 1) | (r & 1));
      const int wu = rr * 4 + w;
      int b, h, qt;
      if (!small) { b = wu >> 10; h = (wu >> 8) & 3; qt = wu & 255; }
      else { b = wu >> 5; h = (wu >> 3) & 3; qt = wu & 7; }
      if (kind == 1) flash_unit<1>(P, l, b, h, small ? 1 : 0, qt * 32);
      else flash_unit<0>(P, l, b, h, small ? 1 : 0, qt * 32);
    }
  }
}

DEVI void phase_ssd_out(const Params& P, int l, float* smem) {
  for (int u = vbid(); u < (l == NLAYER - 1 ? 512 : 528); u += nvb()) {
    int cl = u >> 2, qb = u & 3;
    if (u < 512) {
      const int blk = u >> 1, hf = u & 1, x = blk & 7, i = blk >> 3;
      cl = x * 16 + (i >> 1); qb = (i & 1) * 2 + hf;
    }
    const int cgk = cl < 128 ? ((cl >> 6) * 66 + 2 + (cl & 63)) : (((cl - 128) >> 1) * 66 + ((cl - 128) & 1));
    ssd_s3_unit(P, l, cgk, qb, smem);
  }
}

DEVI void phase_gemm_res(const Params& P, int l, const bf16_t* A, int K, const bf16_t* Bt, int gate, lds_u8* lds, bf16_t* smem, const float* rdlat) {
  {
    pg8::Gemm g{A, Bt, MROWS, 1024, K};
    pg8::MySched S; S.init(64, 4, (int)gridDim.x, (int)blockIdx.x, 1);
    pg8::EpiRes E{P.out, (float*)(P.ws + OFF_HC), (const float*)(P.ws + OFF_MOD) + (size_t)l * 3 * 6144 + gate * 1024, rdlat};
    pg8::gemm_phase<pg8::EpiRes, pg8::MySched, false, true>(lds, g, S, E);
  }
  if (l == NLAYER - 1) return;
  const int kspl = K / 8;
  float* PART = (float*)(P.ws + OFF_PART);
  for (int u = vbid(); u < 256; u += nvb()) {
    int ks = u & 7, tile = u >> 3;
    int tn = tile & 7, ti = tile >> 3;
    int tm = (ti >> 1) * 66 + (ti & 1);
    gemm_tile(A + ks * kspl, K, Bt + ks * kspl, K, kspl, tm * 128, tn * 128, smem, [&](int m, int n, f32x4 v) {
      int bb = m / TOK, t = m - bb * TOK;
      const float* gp = modvec(P, l, 2, gate) + n;
      float4 gv = *(const float4*)gp;
      *(float4*)(PART + ((size_t)ks * 512 + bb * 256 + t) * 1024 + n) = make_float4(gv.x * v[0], gv.y * v[1], gv.z * v[2], gv.w * v[3]);
    });
  }
}

DEVI void phase_mlp1(const Params& P, int l, lds_u8* lds, bf16_t* smem) {
  const bf16_t* A = (const bf16_t*)(P.ws + OFF_A);
  const bf16_t* Bt = (const bf16_t*)(P.ws + OFF_WT1) + (size_t)l * 4096 * 1024;
  bf16_t* H = (bf16_t*)(P.ws + OFF_HID);
  {
    pg8::Gemm g{A, Bt, MROWS, 4096, 1024};
    pg8::MySched S; S.init(64, 16, (int)gridDim.x, (int)blockIdx.x, 1);
    pg8::EpiStore<1> E{H, DFF};
    pg8::gemm_phase<pg8::EpiStore<1>, pg8::MySched, true, true>(lds, g, S, E);
  }
  if (l == NLAYER - 1) return;
  for (int u = vbid(); u < 4 * 32; u += nvb()) {
    int ti = u >> 5, tn = u & 31;
    int tm = (ti >> 1) * 66 + (ti & 1);
    gemm_tile(A, DM, Bt, 1024, 1024, tm * 128, tn * 128, smem, [&](int m, int n, f32x4 v) {
      float a0 = fmaxf(v[0], 0.f), a1 = fmaxf(v[1], 0.f), a2 = fmaxf(v[2], 0.f), a3 = fmaxf(v[3], 0.f);
      *(uint2*)(H + (size_t)m * DFF + n) = make_uint2(pk2(a0 * a0, a1 * a1), pk2(a2 * a2, a3 * a3));
    });
  }
}

constexpr int NPH = 1 + 10 * NLAYER + 1;

constexpr int LDS_HALF = 73728, LDS_BYTES = 2 * LDS_HALF + 64;
__global__ void __launch_bounds__(512, 2) mega(Params P) {
  extern __shared__ __attribute__((aligned(16))) unsigned char lds[];
  lds_u8* ldsg = (lds_u8*)lds;
  volatile unsigned* xbst = (volatile unsigned*)(lds + 2 * LDS_HALF);
  unsigned* bar = (unsigned*)(P.ws + OFF_BAR);
  const unsigned xcc = xb_xcc_id();
  if (threadIdx.x == 0) { xbst[0] = 0u; xbst[1] = 0u; (void)xb_add(&bar[XB_XCNT(xcc)], 1u); }
  __syncthreads();
  for (int ph = P.ph_lo; ph < P.ph_hi; ++ph) {
    Params Q = P;
    { unsigned long long w_ = (unsigned long long)Q.ws, o_ = (unsigned long long)P.out; asm volatile("" : "+s"(w_), "+s"(o_)); Q.ws = (unsigned char*)w_; Q.out = (float*)o_; }
    unsigned char* smem = lds + (rtid() >> 8) * LDS_HALF;
    if (ph == 0) phase_prologue(Q, smem);
    else if (ph == NPH - 1) phase_final(Q);
    else {
      int ph2 = ph; asm volatile("" : "+s"(ph2));
      int l = (ph2 - 1) / 10, s = (ph2 - 1) % 10;
      switch (s) {
        case 0: phase_norm(Q, l, Q.in[I_G1] + l * DM, 0, l > 0, l == 0 ? Q.in[I_X] : Q.out); break;
        case 1: phase_gemm_in(Q, l, ldsg); break;
        case 2: phase_prep(Q, l, smem); phase_mla_gemm(Q, l, (bf16_t*)smem); break;
        case 3: phase_mix(Q, l, (float*)smem, (lds_u32*)(ldsg + (rtid() >> 8) * LDS_HALF + LDS_HALF - 16)); break;
        case 4: phase_ssd_scan(Q); break;
        case 5: phase_ssd_out(Q, l, (float*)smem); break;
        case 6: phase_gemm_res(Q, l, (const bf16_t*)(Q.ws + OFF_A), 1024, (const bf16_t*)(Q.ws + OFF_WTOUT) + (size_t)l * 1024 * 1024, 2, ldsg, (bf16_t*)smem, l == 0 ? Q.in[I_X] : Q.out); break;
        case 7: phase_norm(Q, l, Q.in[I_G2] + l * DM, 3, l < NLAYER - 1, Q.out); break;
        case 8: phase_mlp1(Q, l, ldsg, (bf16_t*)smem); break;
        case 9: phase_gemm_res(Q, l, (const bf16_t*)(Q.ws + OFF_HID), 4096, (const bf16_t*)(Q.ws + OFF_WT2) + (size_t)l * 1024 * 4096, 5, ldsg, (bf16_t*)smem, Q.out); break;
      }
    }
    if (ph + 1 < P.ph_hi) {
      if (P.use_cg) cg::this_grid().sync();
      else xcd_barrier(bar, xcc, xbst);
    }
  }
}

extern "C" void kernel_launch(void* const* d_in, const int* in_sizes, int n_in, void* d_out, int out_size, void* d_ws, size_t ws_size,
                              hipStream_t stream) {
  static int grid_blocks = 0;
  if (!grid_blocks) {
    int dev = 0, cus = 0, per_cu = 0;
    (void)hipGetDevice(&dev);
    (void)hipDeviceGetAttribute(&cus, hipDeviceAttributeMultiprocessorCount, dev);
    if (hipFuncSetAttribute((const void*)mega, hipFuncAttributeMaxDynamicSharedMemorySize, LDS_BYTES) != hipSuccess)
      fprintf(stderr, "hipFuncSetAttribute(MaxDynamicSharedMemorySize) failed\n");
    (void)hipOccupancyMaxActiveBlocksPerMultiprocessor(&per_cu, (const void*)mega, 512, LDS_BYTES);
    if (per_cu < 1) fprintf(stderr, "occupancy query reports %d blocks per CU\n", per_cu);
    (void)hipGetLastError();
    grid_blocks = cus;
  }
  if (ws_size < WS_END) { fprintf(stderr, "workspace too small: %zu < %zu\n", ws_size, (size_t)WS_END); return; }
  Params p{};
  for (int i = 0; i < 25; ++i) p.in[i] = (const float*)d_in[i];
  p.out = (float*)d_out;
  p.ws = (unsigned char*)d_ws;
  p.ph_lo = 0; p.ph_hi = NPH; p.use_cg = 0; p.pad = 0;
  (void)hipMemsetAsync((unsigned char*)d_ws + OFF_BAR, 0, 16384, stream);
  void* args[] = {&p};
  hipError_t e = hipLaunchCooperativeKernel((void*)mega, dim3(grid_blocks), dim3(512), args, LDS_BYTES, stream);
  if (e != hipSuccess) fprintf(stderr, "cooperative launch failed: %s (grid %d)\n", hipGetErrorString(e), grid_blocks);
}
```

```cpp
#include <hip/hip_runtime.h>
#include <hip/hip_cooperative_groups.h>
#include <stdint.h>
#include <stdio.h>
namespace cg = cooperative_groups;

typedef unsigned short bf16_t;
typedef short bf16x8 __attribute__((ext_vector_type(8)));
typedef float f32x4 __attribute__((ext_vector_type(4)));
typedef float f32x16 __attribute__((ext_vector_type(16)));
typedef unsigned u32x4 __attribute__((ext_vector_type(4)));

#define DEVI __device__ __forceinline__

constexpr int SEQ = 8192, LCTX = 256, TOK = 8448, MROWS = 16896, DM = 1024, DFF = 4096, PP = 2816;
constexpr int NLAYER = 4;
constexpr int C_NAQ = 0, C_NAK = 256, C_NAV = 512, C_SWQ = 768, C_SWK = 1024, C_SWV = 1152;
constexpr int C_MCQ = 1280, C_MCKV = 1536, C_MKR = 1664, C_SZ = 1696, C_SX = 1952, C_SB = 2208, C_SC = 2464, C_SDT = 2720;
constexpr int NIN = 2728;
constexpr float LOG2E = 1.4426950408889634f;

constexpr size_t OFF_WTIN = 0;
constexpr size_t OFF_WTOUT = OFF_WTIN + (size_t)4 * PP * 1024 * 2;
constexpr size_t OFF_WT1 = OFF_WTOUT + (size_t)4 * 1024 * 1024 * 2;
constexpr size_t OFF_WT2 = OFF_WT1 + (size_t)4 * 4096 * 1024 * 2;
constexpr size_t OFF_WTUQ = OFF_WT2 + (size_t)4 * 4096 * 1024 * 2;
constexpr size_t OFF_WTUKV = OFF_WTUQ + (size_t)4 * 384 * 256 * 2;
constexpr size_t OFF_ROPE = OFF_WTUKV + (size_t)4 * 512 * 128 * 2;
constexpr size_t OFF_HC = OFF_ROPE + 32768;
constexpr size_t OFF_A = OFF_HC + (size_t)512 * 1024 * 4;
constexpr size_t OFF_P = OFF_A + (size_t)MROWS * 1024 * 2;
constexpr size_t OFF_MQ = OFF_P + (size_t)MROWS * PP * 2;
constexpr size_t OFF_MK = OFF_MQ + (size_t)MROWS * 384 * 2;
constexpr size_t OFF_VTNA = OFF_MK + (size_t)MROWS * 256 * 2;
constexpr size_t OFF_VTSWA = OFF_VTNA + (size_t)2 * 256 * TOK * 2;
constexpr size_t OFF_VTMLA = OFF_VTSWA + (size_t)2 * 128 * TOK * 2;
constexpr size_t OFF_XBC = OFF_VTMLA + (size_t)2 * 256 * TOK * 2;
constexpr size_t OFF_HID = OFF_P;
static_assert(OFF_XBC - OFF_P >= (size_t)MROWS * DFF * 2, "hid alias");
constexpr size_t OFF_XBCT = OFF_XBC + (size_t)MROWS * 768 * 2;
constexpr size_t OFF_DT = OFF_XBCT + (size_t)2 * 512 * TOK * 2;
constexpr size_t OFF_L = OFF_DT + (size_t)MROWS * 8 * 4;
constexpr size_t OFF_CD = OFF_L + (size_t)MROWS * 8 * 4;
constexpr size_t OFF_ST = OFF_CD + 8192;
constexpr size_t OFF_HS = OFF_ST + (size_t)132 * 8 * 8192 * 4;
constexpr size_t OFF_BAR = OFF_HS + (size_t)132 * 8 * 8192 * 2;
constexpr size_t OFF_MOD = OFF_BAR + 16384;
constexpr size_t OFF_PART = OFF_MOD + (size_t)4 * 3 * 6144 * 4;
constexpr size_t WS_END = OFF_PART + (size_t)8 * 512 * 1024 * 4;

struct Params {
  const float* in[25];
  float* out;
  unsigned char* ws;
  int ph_lo, ph_hi;
  int use_cg, pad;
};
enum { I_X = 0, I_C, I_CTX, I_CCTX, I_WMOD, I_BMOD, I_G1, I_WIN, I_RPB, I_SINK, I_GQ, I_GKV, I_WUQ, I_WUKV, I_CONVW, I_CONVB,
       I_DTB, I_ALOG, I_SSDD, I_SSDG, I_WOUT, I_G2, I_W1, I_W2, I_GF };

DEVI unsigned short f2bf(float f) {
  unsigned u = __float_as_uint(f);
  u += 0x7fffu + ((u >> 16) & 1u);
  return (unsigned short)(u >> 16);
}
DEVI float bf2f(unsigned short h) { return __uint_as_float(((unsigned)h) << 16); }
typedef float f32x2_t __attribute__((ext_vector_type(2)));
typedef __bf16 bf16x2_t __attribute__((ext_vector_type(2)));
DEVI unsigned pk2(float lo, float hi) { f32x2_t v = {lo, hi}; bf16x2_t b = __builtin_convertvector(v, bf16x2_t); return __builtin_bit_cast(unsigned, b); }
DEVI float bflo(unsigned u) { return __uint_as_float(u << 16); }
DEVI float bfhi(unsigned u) { return __uint_as_float(u & 0xffff0000u); }
DEVI float siluf(float x) { return x / (1.f + __expf(-x)); }
DEVI float softplusf(float x) {
  if (x > 20.f) return x;
  float e = __expf(x);
  return e < 0.01f ? e * (1.f - e * (0.5f - e * (0.33333334f - 0.25f * e))) : __logf(1.f + e);
}
DEVI float2 cossin_reduced(float ang) {
  float n = rintf(ang * 0.15915494309189535f);
  float r = fmaf(-n, 6.28318548202514648f, ang);
  r = fmaf(-n, -1.74845553e-07f, r);
  return make_float2(__cosf(r), __sinf(r));
}
DEVI float ex2(float x) { return __builtin_amdgcn_exp2f(x); }
DEVI float max3f(float a, float b, float c) { float r; asm("v_max3_f32 %0, %1, %2, %3" : "=v"(r) : "v"(a), "v"(b), "v"(c)); return r; }
DEVI f32x16 mfma32(bf16x8 a, bf16x8 b, f32x16 c) { return __builtin_amdgcn_mfma_f32_32x32x16_bf16(a, b, c, 0, 0, 0); }
DEVI f32x4 mfma16(bf16x8 a, bf16x8 b, f32x4 c) { return __builtin_amdgcn_mfma_f32_16x16x32_bf16(a, b, c, 0, 0, 0); }
DEVI bf16x8 ld8(const bf16_t* p) { return *(const bf16x8*)p; }
DEVI bf16x8 mk8(unsigned a, unsigned b, unsigned c, unsigned d) {
  uint4 u = make_uint4(a, b, c, d);
  return __builtin_bit_cast(bf16x8, u);
}
DEVI bf16x8 ld4x2(const bf16_t* p0, const bf16_t* p1) {
  uint2 a = *(const uint2*)p0;
  uint2 b = *(const uint2*)p1;
  return mk8(a.x, a.y, b.x, b.y);
}
DEVI int rtid() { int t = threadIdx.x; asm volatile("" : "+v"(t)); return t; }
DEVI int otid() { int t = threadIdx.x & 255; asm volatile("" : "+v"(t)); return t; }
DEVI int vbid() { return blockIdx.x * 2 + (rtid() >> 8); }
DEVI int nvb() { return gridDim.x * 2; }
DEVI float wave_sum(float v) {
#pragma unroll
  for (int o = 32; o >= 1; o >>= 1) v += __shfl_xor(v, o);
  return v;
}
DEVI float* hrow(const Params& P, int m) {
  int b = m / TOK, t = m - b * TOK;
  return t < LCTX ? (float*)(P.ws + OFF_HC) + (size_t)(b * LCTX + t) * DM : P.out + (size_t)(b * SEQ + t - LCTX) * DM;
}
DEVI int modrow(int m) {
  int b = m / TOK, t = m - b * TOK;
  return t < LCTX ? 2 : b;
}
DEVI const float* modvec(const Params& P, int l, int r, int which) {
  return (const float*)(P.ws + OFF_MOD) + ((size_t)(l * 3 + r) * 6 + which) * DM;
}


#define LAS __attribute__((address_space(3)))
#define XB_TMO      128
#define XB_XCNT(j)  (256  + 64 * (j))
#define XB_XSUB(j)  (1280 + 64 * (j))
#define XB_XGEN(j)  (2304 + 64 * (j))
#define XB_TOP      3328
#define XB_TOPGEN   3392
#define XCD_BAR_WORDS 3456
#define XB_SPIN_CAP (1u << 20)
DEVI unsigned xb_ld(unsigned* p) { return __hip_atomic_load(p, __ATOMIC_RELAXED, __HIP_MEMORY_SCOPE_AGENT); }
DEVI unsigned xb_add(unsigned* p, unsigned v) { return __hip_atomic_fetch_add(p, v, __ATOMIC_RELAXED, __HIP_MEMORY_SCOPE_AGENT); }
DEVI unsigned xb_xcc_id() { return (unsigned)__builtin_amdgcn_s_getreg((3 << 11) | 20) & 0xFu; }
#define XB_SPIN(cond, bar) do { unsigned _sp = 0; while (cond) { __builtin_amdgcn_s_sleep(1); \
    if ((++_sp & 255u) == 0u) { if (xb_ld(&(bar)[XB_TMO])) break; if (_sp > XB_SPIN_CAP) { atomicAdd(&(bar)[XB_TMO], 1u); break; } } } } while (0)
DEVI void xcd_barrier_complete(unsigned* bar, unsigned x, unsigned& nloc, unsigned& nx) {
  const unsigned G = gridDim.x;
  unsigned sum, cnt, mine, sp = 0u;
  for (;;) {
    sum = 0u; cnt = 0u; mine = 0u;
#pragma unroll
    for (unsigned j = 0; j < 16; ++j) { const unsigned c = xb_ld(&bar[XB_XCNT(j)]); sum += c; cnt += (c > 0u) ? 1u : 0u; mine = (j == x) ? c : mine; }
    if (sum == G) break;
    __builtin_amdgcn_s_sleep(1);
    if ((++sp & 255u) == 0u) { if (xb_ld(&bar[XB_TMO])) break; if (sp > XB_SPIN_CAP) { atomicAdd(&bar[XB_TMO], 1u); break; } }
  }
  nloc = mine > 0u ? mine : 1u; nx = cnt > 0u ? cnt : 1u;
}
DEVI void xcd_barrier(unsigned* bar, unsigned x, volatile unsigned* st) {
  asm volatile("s_waitcnt vmcnt(0)" ::: "memory");
  __syncthreads();
  if (threadIdx.x == 0) {
    __builtin_amdgcn_s_waitcnt(0);
    unsigned nloc = st[0], nx = st[1];
    if (nloc == 0u) { xcd_barrier_complete(bar, x, nloc, nx); st[0] = nloc; st[1] = nx; }
    const unsigned old = xb_add(&bar[XB_XSUB(x)], 1u);
    const unsigned gen = old / nloc;
    if (old + 1u == (gen + 1u) * nloc) {
      __builtin_amdgcn_fence(__ATOMIC_RELEASE, "agent");
      asm volatile("s_waitcnt vmcnt(0)" ::: "memory");
      const unsigned og = xb_add(&bar[XB_TOP], 1u);
      const unsigned tg = og / nx;
      if (og + 1u == (tg + 1u) * nx) xb_add(&bar[XB_TOPGEN], 1u);
      else XB_SPIN(xb_ld(&bar[XB_TOPGEN]) == tg, bar);
      __builtin_amdgcn_fence(__ATOMIC_ACQUIRE, "agent");
      xb_add(&bar[XB_XGEN(x)], 1u);
      asm volatile("s_waitcnt vmcnt(0)" ::: "memory");
    } else {
      XB_SPIN(xb_ld(&bar[XB_XGEN(x)]) == gen, bar);
      __builtin_amdgcn_fence(__ATOMIC_ACQUIRE, "agent");
      asm volatile("s_waitcnt vmcnt(0)" ::: "memory");
    }
  }
  __syncthreads();
}

namespace pg8 {
#define PG8_LAS __attribute__((address_space(3)))
typedef unsigned short bf16_t;
typedef short bf16x8 __attribute__((ext_vector_type(8)));
typedef float f32x4 __attribute__((ext_vector_type(4)));
typedef unsigned u32x4 __attribute__((ext_vector_type(4)));
constexpr int BM = 256, BK = 64, HALF = 128, HTB = HALF * BK * 2  , STAGE_BYTES = 8 * HTB, NXCD = 8, WGM = 8;

__host__ __device__ __forceinline__ int lds_byte(int r, int c) { const int st = (r >> 4) * 2 + (c >> 5), rr = r & 15, cc = c & 31, ob = rr * 64 + cc * 2; return st * 1024 + (ob ^ (((ob >> 9) & 1) << 5)); }
__host__ __device__ __forceinline__ void stage_rc(int b, int& R, int& C) { const int st = b / 1024, sb = b % 1024, swz = sb ^ (((sb >> 9) & 1) << 5); R = (st >> 1) * 16 + swz / 64; C = (st & 1) * 32 + (swz % 64) / 2; }
__host__ __device__ __forceinline__ int perm32(int rho) { const int n = rho >> 4, i = rho & 15; return 8 * (i >> 2) + 4 * n + (i & 3); }

struct Unit { int pm, pn; };
struct Gemm { const bf16_t* A; const bf16_t* Bt; int M, N, K; };

struct MySched {
    int nM, nN, nwg, G, c, lat;
    __device__ __forceinline__ void init(int nM_, int nN_, int G_, int c_, int lat_) { nM = nM_; nN = nN_; nwg = nM * nN; G = G_; c = c_; lat = lat_; }
    __device__ __forceinline__ bool next(int i, Unit& u) const {
        const long L = (long)i * G + c; if (L >= nwg) return false;
        int wgid = (int)L; { const int q = nwg / NXCD, r = nwg % NXCD, xcd = wgid % NXCD, off = wgid / NXCD; wgid = (xcd < r ? xcd * (q + 1) : r * (q + 1) + (xcd - r) * q) + off; }
        const int nig = WGM * nN, gid = wgid / nig, fm = gid * WGM, gsz = (nM - fm) < WGM ? (nM - fm) : WGM;
        int pm = fm + ((wgid % nig) % gsz); u.pn = (wgid % nig) / gsz;
        u.pm = lat ? ((pm >> 5) * 33 + 1 + (pm & 31)) : pm;
        return true;
    }
    __device__ __forceinline__ void a_ready(const Unit&) const {}
    __device__ __forceinline__ void done(const Unit&) const {}
};
__device__ __forceinline__ unsigned cvtpk(float lo, float hi) { typedef float f2 __attribute__((ext_vector_type(2))); typedef __bf16 b2 __attribute__((ext_vector_type(2))); f2 v = {lo, hi}; b2 b = __builtin_convertvector(v, b2); return __builtin_bit_cast(unsigned, b); }
template <int ACT> struct EpiStore {
    static constexpr bool PERM = true, AFTER_DRAIN = false;
    bf16_t* O; int ldc;
    __device__ __forceinline__ void operator()(const f32x4 (&acc)[2][2][4][2], const Unit& u, int wr, int wc, int fr, int fq) const {
        const int row0 = u.pm * BM + wr * 64 + fr, col0 = u.pn * BM + wc * 32 + 8 * fq;
#pragma unroll
        for (int ai = 0; ai < 2; ++ai)
#pragma unroll
            for (int m = 0; m < 4; ++m) { bf16_t* rowp = O + (size_t)(row0 + ai * HALF + m * 16) * ldc + col0;
#pragma unroll
                for (int bj = 0; bj < 2; ++bj) { f32x4 v0 = acc[ai][bj][m][0], v1 = acc[ai][bj][m][1];
                    if (ACT == 1) {
#pragma unroll
                        for (int e = 0; e < 4; ++e) { float a = v0[e] > 0.f ? v0[e] : 0.f, b = v1[e] > 0.f ? v1[e] : 0.f; v0[e] = a * a; v1[e] = b * b; } }
                    u32x4 w; w.x = cvtpk(v0[0], v0[1]); w.y = cvtpk(v0[2], v0[3]); w.z = cvtpk(v1[0], v1[1]); w.w = cvtpk(v1[2], v1[3]);
                    *(u32x4*)(rowp + bj * HALF) = w; } }
    }
};
struct EpiRes {
    static constexpr bool PERM = true, AFTER_DRAIN = false;
    float* out; float* hc; const float* gvec; const float* rdlat;
    __device__ __forceinline__ void operator()(const f32x4 (&acc)[2][2][4][2], const Unit& u, int wr, int wc, int fr, int fq) const {
        const int bb = u.pm / 33, tt = u.pm - bb * 33;
        const int r = tt == 0 ? 2 : bb;
        const int col0 = u.pn * BM + wc * 32 + 8 * fq;
        float* base = tt == 0 ? hc + (size_t)(bb * 256) * 1024 : out + (size_t)(bb * 8192 + (tt - 1) * 256) * 1024;
        const float* gp = gvec + (size_t)r * 6144 + col0;
        float* rowb = base + (size_t)(wr * 64 + fr) * 1024 + col0;
        const float* rowr = (tt == 0) ? rowb : rdlat + (rowb - out);
#pragma unroll
        for (int bj = 0; bj < 2; ++bj)
#pragma unroll
            for (int n = 0; n < 2; ++n) { const f32x4 gv = *(const f32x4*)(gp + bj * HALF + 4 * n);
#pragma unroll
                for (int ai = 0; ai < 2; ++ai)
#pragma unroll
                    for (int m = 0; m < 4; ++m) { const size_t off = (size_t)(ai * HALF + m * 16) * 1024 + bj * HALF + 4 * n; f32x4 hv = *(const f32x4*)(rowr + off); hv = hv + gv * acc[ai][bj][m][n]; *(f32x4*)(rowb + off) = hv; } }
    }
};

template <class Epi, class Sched, bool ALIGN_EPI = false, bool SP2 = false>
__device__ __forceinline__ void gemm_phase(PG8_LAS unsigned char* lds, const Gemm g, const Sched& S, const Epi& E) {
    int tid = threadIdx.x; asm volatile("" : "+v"(tid));
    const int wid = __builtin_amdgcn_readfirstlane(tid >> 6), lane = tid & 63, wr = wid >> 2, wc = wid & 3, fr = lane & 15, fq = lane >> 4;
    const int K = g.K, nt = K / BK;
    unsigned voffA[2], voffB[2];
#pragma unroll
    for (int i = 0; i < 2; ++i) { int R, C; stage_rc(tid * 16 + i * 8192, R, C); const int Rb = Epi::PERM ? ((R & ~31) + perm32(R & 31)) : R;
        voffA[i] = (unsigned)(R * K + C) * 2u; voffB[i] = (unsigned)(Rb * K + C) * 2u; }
    const size_t kstep = (size_t)(BK * 2);
    const size_t hstep = (size_t)HALF * K * 2;
    const size_t tstep = 2 * hstep;
    const unsigned ldsw = (unsigned)wid * 1024u;
    const int aoff = lds_byte(wr * 64 + fr, fq * 8), boff = lds_byte(wc * 32 + fr, fq * 8);
#define PG8_SA(b, h) (((b) * 2 + (h)) * HTB)
#define PG8_SB(b, h) ((4 + (b) * 2 + (h)) * HTB)
#define PG8_STAGE(bufoff, gbase, voff) do { _Pragma("unroll") for (int _i = 0; _i < 2; ++_i) \
        __builtin_amdgcn_global_load_lds((const unsigned*)((const char*)(gbase) + (voff)[_i]), (PG8_LAS unsigned*)(lds + (bufoff) + ldsw + _i * 8192), 16, 0, 0); } while (0)
#define PG8_LDA(dst, b, h) do { _Pragma("unroll") for (int m = 0; m < 4; ++m) _Pragma("unroll") for (int k = 0; k < 2; ++k) dst[m][k] = *(const PG8_LAS bf16x8*)(lds + PG8_SA(b, h) + aoff + m * 2048 + k * 1024); } while (0)
#define PG8_LDB(dst, b, h) do { _Pragma("unroll") for (int n = 0; n < 2; ++n) _Pragma("unroll") for (int k = 0; k < 2; ++k) dst[n][k] = *(const PG8_LAS bf16x8*)(lds + PG8_SB(b, h) + boff + n * 2048 + k * 1024); } while (0)
#define PG8_MMA(ai, bj, At, Bt) do { __builtin_amdgcn_s_setprio(1); _Pragma("unroll") for (int m = 0; m < 4; ++m) _Pragma("unroll") for (int n = 0; n < 2; ++n) _Pragma("unroll") for (int k = 0; k < 2; ++k) \
        acc[ai][bj][m][n] = __builtin_amdgcn_mfma_f32_16x16x32_bf16(Bt[n][k], At[m][k], acc[ai][bj][m][n], 0, 0, 0); __builtin_amdgcn_s_setprio(0); } while (0)
#define PG8_WAIT_V(n) asm volatile("s_waitcnt vmcnt(" #n ")" ::: "memory")
#define PG8_WAIT_L(n) asm volatile("s_waitcnt lgkmcnt(" #n ")" ::: "memory")
#define PG8_BAR __builtin_amdgcn_s_barrier()
#define PG8_SCHED __builtin_amdgcn_sched_barrier(0)
    Unit cur, nxt; int ui = 0;
    if (!S.next(0, cur)) return;
    f32x4 acc[2][2][4][2];
#pragma unroll
    for (int a = 0; a < 2; ++a)
#pragma unroll
        for (int b = 0; b < 2; ++b)
#pragma unroll
            for (int m = 0; m < 4; ++m)
#pragma unroll
                for (int n = 0; n < 2; ++n) acc[a][b][m][n] = (f32x4){0.f, 0.f, 0.f, 0.f};
    bf16x8 At[4][2], B0[2][2], B1[2][2];
    const char* cA = (const char*)g.A + (size_t)cur.pm * tstep; const char* cB = (const char*)g.Bt + (size_t)cur.pn * tstep;
    S.a_ready(cur);
    if constexpr (SP2) {
        PG8_STAGE(PG8_SB(0, 0), cB, voffB); PG8_STAGE(PG8_SB(0, 1), cB + hstep, voffB); PG8_STAGE(PG8_SA(0, 0), cA, voffA); PG8_STAGE(PG8_SA(0, 1), cA + hstep, voffA);
        if (wr == 1) PG8_BAR;
        PG8_WAIT_V(2); PG8_BAR;
        PG8_STAGE(PG8_SB(1, 0), cB + kstep, voffB); PG8_STAGE(PG8_SA(1, 0), cA + kstep, voffA); PG8_STAGE(PG8_SB(1, 1), cB + hstep + kstep, voffB);
        PG8_WAIT_V(6); PG8_BAR;
    } else {
        PG8_STAGE(PG8_SB(0, 0), cB, voffB); PG8_STAGE(PG8_SA(0, 0), cA, voffA); PG8_STAGE(PG8_SB(0, 1), cB + hstep, voffB); PG8_STAGE(PG8_SA(0, 1), cA + hstep, voffA);
        if (wr == 1) PG8_BAR;
        PG8_WAIT_V(4); PG8_BAR;
        PG8_STAGE(PG8_SB(1, 0), cB + kstep, voffB); PG8_STAGE(PG8_SA(1, 0), cA + kstep, voffA); PG8_STAGE(PG8_SB(1, 1), cB + hstep + kstep, voffB);
        PG8_WAIT_V(6); PG8_BAR;
    }
    for (;;) {
        const bool has_next = S.next(ui + 1, nxt);
        const char* nA = has_next ? (const char*)g.A + (size_t)nxt.pm * tstep : cA; const char* nB = has_next ? (const char*)g.Bt + (size_t)nxt.pn * tstep : cB;
        for (int t = 0; t < nt; t += 2) {
            const bool last = (t == nt - 2);
            const char* a1 = cA + (size_t)(t + 1) * kstep;
            const char* a2 = last ? nA : cA + (size_t)(t + 2) * kstep; const char* b2 = last ? nB : cB + (size_t)(t + 2) * kstep;
            const char* a3 = a2 + kstep; const char* b3 = b2 + kstep;
            if (last && has_next) S.a_ready(nxt);
            if constexpr (SP2) {
            PG8_LDB(B0, 0, 0); PG8_LDB(B1, 0, 1); PG8_SCHED; PG8_LDA(At, 0, 0); PG8_STAGE(PG8_SA(1, 1), a1 + hstep, voffA);
            PG8_WAIT_V(8); PG8_WAIT_L(0); PG8_BAR; PG8_MMA(0, 0, At, B0); PG8_MMA(0, 1, At, B1); PG8_BAR; PG8_SCHED;
            PG8_LDA(At, 0, 1); PG8_STAGE(PG8_SB(0, 0), b2, voffB); PG8_STAGE(PG8_SB(0, 1), b2 + hstep, voffB); PG8_STAGE(PG8_SA(0, 0), a2, voffA);
            PG8_WAIT_V(8); PG8_WAIT_L(0); PG8_BAR; PG8_MMA(1, 0, At, B0); PG8_MMA(1, 1, At, B1); PG8_BAR; PG8_SCHED;
            PG8_LDB(B0, 1, 0); PG8_LDB(B1, 1, 1); PG8_SCHED; PG8_LDA(At, 1, 0); PG8_STAGE(PG8_SA(0, 1), a2 + hstep, voffA);
            PG8_WAIT_V(8); PG8_WAIT_L(0); PG8_BAR; PG8_MMA(0, 0, At, B0); PG8_MMA(0, 1, At, B1); PG8_BAR; PG8_SCHED;
            PG8_LDA(At, 1, 1); PG8_STAGE(PG8_SB(1, 0), b3, voffB); PG8_STAGE(PG8_SB(1, 1), b3 + hstep, voffB); PG8_STAGE(PG8_SA(1, 0), a3, voffA);
            PG8_WAIT_V(8); PG8_WAIT_L(0); PG8_BAR; PG8_MMA(1, 0, At, B0); PG8_MMA(1, 1, At, B1); PG8_BAR; PG8_SCHED;
            } else {
            PG8_LDB(B0, 0, 0); PG8_SCHED; PG8_LDA(At, 0, 0); PG8_STAGE(PG8_SA(1, 1), a1 + hstep, voffA);
            PG8_WAIT_L(8); PG8_BAR; PG8_WAIT_L(0); PG8_MMA(0, 0, At, B0); PG8_BAR; PG8_SCHED;
            PG8_LDB(B1, 0, 1); PG8_STAGE(PG8_SB(0, 0), b2, voffB);
            PG8_BAR; PG8_WAIT_L(0); PG8_MMA(0, 1, At, B1); PG8_BAR;
            PG8_LDA(At, 0, 1); PG8_STAGE(PG8_SA(0, 0), a2, voffA);
            PG8_BAR; PG8_WAIT_L(0); PG8_MMA(1, 0, At, B0); PG8_BAR; PG8_SCHED;
            PG8_STAGE(PG8_SB(0, 1), b2 + hstep, voffB);
            PG8_WAIT_V(6); PG8_BAR; PG8_MMA(1, 1, At, B1); PG8_BAR;
            PG8_LDB(B0, 1, 0); PG8_SCHED; PG8_LDA(At, 1, 0); PG8_STAGE(PG8_SA(0, 1), a2 + hstep, voffA);
            PG8_WAIT_L(8); PG8_BAR; PG8_WAIT_L(0); PG8_MMA(0, 0, At, B0); PG8_BAR; PG8_SCHED;
            PG8_LDB(B1, 1, 1); PG8_STAGE(PG8_SB(1, 0), b3, voffB);
            PG8_BAR; PG8_WAIT_L(0); PG8_MMA(0, 1, At, B1); PG8_BAR;
            PG8_LDA(At, 1, 1); PG8_STAGE(PG8_SA(1, 0), a3, voffA);
            PG8_BAR; PG8_WAIT_L(0); PG8_MMA(1, 0, At, B0); PG8_BAR; PG8_SCHED;
            PG8_STAGE(PG8_SB(1, 1), b3 + hstep, voffB);
            PG8_WAIT_V(6); PG8_BAR; PG8_MMA(1, 1, At, B1); PG8_BAR;
            }
        }
        if constexpr (ALIGN_EPI) { if (wr == 0) PG8_BAR; }
        if constexpr (!Epi::AFTER_DRAIN) { E(acc, cur, wr, wc, fr, fq); S.done(cur); }
        if (!has_next) break;
#pragma unroll
        for (int a = 0; a < 2; ++a)
#pragma unroll
            for (int b = 0; b < 2; ++b)
#pragma unroll
                for (int m = 0; m < 4; ++m)
#pragma unroll
                    for (int n = 0; n < 2; ++n) acc[a][b][m][n] = (f32x4){0.f, 0.f, 0.f, 0.f};
        cur = nxt; cA = nA; cB = nB; ++ui;
        if constexpr (ALIGN_EPI) { if (wr == 1) PG8_BAR; }
    }
    PG8_WAIT_V(0);
    if constexpr (!ALIGN_EPI) { if (wr == 0) PG8_BAR; }
    PG8_BAR;
    if constexpr (Epi::AFTER_DRAIN) { E.fused(acc, cur, wr, wc, fr, fq, lds, wid, lane); S.done(cur); }
#undef PG8_SA
#undef PG8_SB
#undef PG8_STAGE
#undef PG8_LDA
#undef PG8_LDB
#undef PG8_MMA
#undef PG8_WAIT_V
#undef PG8_WAIT_L
#undef PG8_BAR
#undef PG8_SCHED
}
}

struct TrJob { const float* W; bf16_t* Wt; int K, N, tk, tn; const float* gk; };
DEVI TrJob tr_job(const Params& P, int u) {
  TrJob j;
  j.gk = nullptr;
  int l = u / 3048, r = u % 3048;
  if (r < 704) { j.W = P.in[I_WIN] + (size_t)l * 1024 * NIN; j.K = 1024; j.N = NIN; j.Wt = (bf16_t*)(P.ws + OFF_WTIN) + (size_t)l * PP * 1024; j.tk = r / 44; j.tn = r % 44; }
  else if ((r -= 704) < 256) { j.W = P.in[I_WOUT] + (size_t)l * 1024 * 1024; j.K = 1024; j.N = 1024; j.Wt = (bf16_t*)(P.ws + OFF_WTOUT) + (size_t)l * 1024 * 1024; j.tk = r / 16; j.tn = r % 16; }
  else if ((r -= 256) < 1024) { j.W = P.in[I_W1] + (size_t)l * 1024 * 4096; j.K = 1024; j.N = 4096; j.Wt = (bf16_t*)(P.ws + OFF_WT1) + (size_t)l * 4096 * 1024; j.tk = r / 64; j.tn = r % 64; }
  else if ((r -= 1024) < 1024) { j.W = P.in[I_W2] + (size_t)l * 4096 * 1024; j.K = 4096; j.N = 1024; j.Wt = (bf16_t*)(P.ws + OFF_WT2) + (size_t)l * 1024 * 4096; j.tk = r / 16; j.tn = r % 16; }
  else if ((r -= 1024) < 24) { j.W = P.in[I_WUQ] + (size_t)l * 256 * 384; j.K = 256; j.N = 384; j.Wt = (bf16_t*)(P.ws + OFF_WTUQ) + (size_t)l * 384 * 256; j.tk = r / 6; j.tn = r % 6; j.gk = P.in[I_GQ] + l * 256; }
  else { r -= 24; j.W = P.in[I_WUKV] + (size_t)l * 128 * 512; j.K = 128; j.N = 512; j.Wt = (bf16_t*)(P.ws + OFF_WTUKV) + (size_t)l * 512 * 128; j.tk = r / 8; j.tn = r % 8; j.gk = P.in[I_GKV] + l * 128; }
  return j;
}
DEVI void tr_load(const TrJob& j, int tid, float4 (&v)[4]) {
  const int r = tid >> 4, c4 = (tid & 15) * 4;
  const int n = j.tn * 64 + c4;
#pragma unroll
  for (int i = 0; i < 4; ++i)
    v[i] = (n < j.N) ? *(const float4*)(j.W + (size_t)(j.tk * 64 + r + 16 * i) * j.N + n) : make_float4(0.f, 0.f, 0.f, 0.f);
}
DEVI void tr_lds(int tid, float* tile, const float4 (&v)[4]) {
  const int r = tid >> 4, c4 = (tid & 15) * 4;
#pragma unroll
  for (int i = 0; i < 4; ++i) { float* tp = tile + (r + 16 * i) * 65 + c4; tp[0] = v[i].x; tp[1] = v[i].y; tp[2] = v[i].z; tp[3] = v[i].w; }
}
DEVI void tr_store(const TrJob& j, int tid, const float* tile) {
  const int kc = tid & 7;
#pragma unroll
  for (int i = 0; i < 2; ++i) {
    int nl = (tid >> 3) + 32 * i;
    const float* tp = tile + (kc * 8) * 65 + nl;
    float g0 = 1.f, g1 = 1.f, g2 = 1.f, g3 = 1.f, g4 = 1.f, g5 = 1.f, g6 = 1.f, g7 = 1.f;
    if (j.gk) { const float* gp = j.gk + j.tk * 64 + kc * 8; g0 = gp[0]; g1 = gp[1]; g2 = gp[2]; g3 = gp[3]; g4 = gp[4]; g5 = gp[5]; g6 = gp[6]; g7 = gp[7]; }
    uint4 w;
    w.x = pk2(tp[0 * 65] * g0, tp[1 * 65] * g1);
    w.y = pk2(tp[2 * 65] * g2, tp[3 * 65] * g3);
    w.z = pk2(tp[4 * 65] * g4, tp[5 * 65] * g5);
    w.w = pk2(tp[6 * 65] * g6, tp[7 * 65] * g7);
    *(uint4*)(j.Wt + (size_t)(j.tn * 64 + nl) * j.K + j.tk * 64 + kc * 8) = w;
  }
}

DEVI void phase_prologue(const Params& P, unsigned char* smem) {
  const int tid = otid();
  {
    float* tile0 = (float*)smem;
    float* tile1 = tile0 + 64 * 65;
    for (int u = vbid(); u < 4 * 3048; u += 2 * nvb()) {
      const int u1 = u + nvb();
      const bool has1 = u1 < 4 * 3048;
      TrJob j0 = tr_job(P, u), j1 = tr_job(P, has1 ? u1 : u);
      float4 v0[4], v1[4];
      tr_load(j0, tid, v0);
      tr_load(j1, tid, v1);
      tr_lds(tid, tile0, v0);
      tr_lds(tid, tile1, v1);
      __syncthreads();
      tr_store(j0, tid, tile0);
      if (has1) tr_store(j1, tid, tile1);
      __syncthreads();
    }
  }
  {
    float* sc = (float*)smem;
    float* red = sc + 3 * 1024;
    for (int i = tid; i < 3 * 1024; i += 256) {
      int r = i >> 10, k = i & 1023;
      float v = (r < 2) ? P.in[I_C][r * 1024 + k] : P.in[I_CCTX][k];
      sc[i] = siluf(v);
    }
    __syncthreads();
    const int w = tid >> 6, lane = tid & 63, rg = lane >> 4, c4 = (lane & 15) * 4;
    float* MOD = (float*)(P.ws + OFF_MOD);
    for (int u = vbid(); u < 4 * 96; u += nvb()) {
      const int l = u / 96, cgp = u - l * 96;
      const int kb = w * 256 + rg;
      const float* W = P.in[I_WMOD] + ((size_t)l * 1024 + kb) * 6144 + cgp * 64 + c4;
      float4 a0 = make_float4(0.f, 0.f, 0.f, 0.f), a1 = a0, a2 = a0;
#pragma unroll 1
      for (int ib = 0; ib < 64; ib += 16) {
        float4 wv[16];
#pragma unroll
        for (int i = 0; i < 16; ++i) wv[i] = *(const float4*)(W + (size_t)(ib + i) * 4 * 6144);
#pragma unroll
        for (int i = 0; i < 16; ++i) {
          const int k = kb + 4 * (ib + i);
          float s0 = sc[k], s1 = sc[1024 + k], s2 = sc[2048 + k];
          a0.x += s0 * wv[i].x; a0.y += s0 * wv[i].y; a0.z += s0 * wv[i].z; a0.w += s0 * wv[i].w;
          a1.x += s1 * wv[i].x; a1.y += s1 * wv[i].y; a1.z += s1 * wv[i].z; a1.w += s1 * wv[i].w;
          a2.x += s2 * wv[i].x; a2.y += s2 * wv[i].y; a2.z += s2 * wv[i].z; a2.w += s2 * wv[i].w;
        }
      }
#pragma unroll
      for (int o = 16; o <= 32; o <<= 1) {
        a0.x += __shfl_xor(a0.x, o); a0.y += __shfl_xor(a0.y, o); a0.z += __shfl_xor(a0.z, o); a0.w += __shfl_xor(a0.w, o);
        a1.x += __shfl_xor(a1.x, o); a1.y += __shfl_xor(a1.y, o); a1.z += __shfl_xor(a1.z, o); a1.w += __shfl_xor(a1.w, o);
        a2.x += __shfl_xor(a2.x, o); a2.y += __shfl_xor(a2.y, o); a2.z += __shfl_xor(a2.z, o); a2.w += __shfl_xor(a2.w, o);
      }
      if (rg == 0) {
        *(float4*)(red + (w * 3 + 0) * 64 + c4) = a0;
        *(float4*)(red + (w * 3 + 1) * 64 + c4) = a1;
        *(float4*)(red + (w * 3 + 2) * 64 + c4) = a2;
      }
      __syncthreads();
      if (tid < 192) {
        int rr = tid >> 6, c = tid & 63;
        float sum = red[(0 * 3 + rr) * 64 + c] + red[(1 * 3 + rr) * 64 + c] + red[(2 * 3 + rr) * 64 + c] + red[(3 * 3 + rr) * 64 + c];
        sum += P.in[I_BMOD][l * 6144 + cgp * 64 + c];
        MOD[(size_t)(l * 3 + rr) * 6144 + cgp * 64 + c] = sum;
      }
      __syncthreads();
    }
  }
  {
    int gt = vbid() * 256 + tid;
    if (gt < 128 * 16) {
      int pos = gt >> 4, i = gt & 15;
      float inv = exp2f(-(float)i * (13.287712379549449f / 16.f));
      float ang = (float)pos * inv;
      ((float2*)(P.ws + OFF_ROPE))[gt] = cossin_reduced(ang);
    } else if (gt < 128 * 16 + 128 * 8) {
      int g2 = gt - 128 * 16;
      int pos = g2 >> 3, i = g2 & 7;
      float inv = exp2f(-(float)i * (13.287712379549449f / 8.f));
      float ang = (float)pos * inv;
      ((float2*)(P.ws + OFF_ROPE + 16384))[g2] = cossin_reduced(ang);
    }
  }
  {
    const size_t stride = (size_t)nvb() * 256;
    const float4* cs = (const float4*)P.in[I_CTX];
    float4* cd = (float4*)(P.ws + OFF_HC);
    const size_t c4 = (size_t)2 * LCTX * DM / 4;
    for (size_t i = (size_t)vbid() * 256 + tid; i < c4; i += stride) cd[i] = cs[i];
  }
}

DEVI void phase_norm(const Params& P, int l, const float* g, int which0, bool pend, const float* latsrc) {
  const int tid = otid(), w = tid >> 6, lane = tid & 63;
  bf16_t* A = (bf16_t*)(P.ws + OFF_A);
  const int nw = nvb() * 4;
  auto load_row = [&](int m, float4 (&v)[4]) {
    const int r = modrow(m);
    const float* hr = (r == 2) ? hrow(P, m) : latsrc + (hrow(P, m) - P.out);
#pragma unroll
    for (int j = 0; j < 4; ++j) v[j] = *(const float4*)(hr + j * 256 + lane * 4);
    if (pend && r == 2) {
      int bb = m / TOK, t = m - bb * TOK;
      const float* pp = (const float*)(P.ws + OFF_PART) + (size_t)(bb * 256 + t) * 1024 + lane * 4;
#pragma unroll 1
      for (int ks = 0; ks < 8; ++ks) {
#pragma unroll
        for (int j = 0; j < 4; ++j) {
          float4 a = *(const float4*)(pp + (size_t)ks * 512 * 1024 + j * 256);
          v[j].x += a.x; v[j].y += a.y; v[j].z += a.z; v[j].w += a.w;
        }
      }
#pragma unroll
      for (int j = 0; j < 4; ++j) *(float4*)((float*)hr + j * 256 + lane * 4) = v[j];
    }
  };
  auto finish_row = [&](int m, const float4 (&v)[4]) {
    const int r = modrow(m);
    const float* sh = modvec(P, l, r, which0);
    const float* scl = modvec(P, l, r, which0 + 1);
    float ss = 0.f;
#pragma unroll
    for (int j = 0; j < 4; ++j) ss += v[j].x * v[j].x + v[j].y * v[j].y + v[j].z * v[j].z + v[j].w * v[j].w;
    ss = wave_sum(ss);
    float rstd = rsqrtf(ss * (1.f / 1024.f) + 1e-6f);
#pragma unroll
    for (int j = 0; j < 4; ++j) {
      int c = j * 256 + lane * 4;
      float4 gg = *(const float4*)(g + c);
      float4 s4 = *(const float4*)(sh + c);
      float4 c4 = *(const float4*)(scl + c);
      float o0 = v[j].x * rstd * gg.x * (1.f + c4.x) + s4.x;
      float o1 = v[j].y * rstd * gg.y * (1.f + c4.y) + s4.y;
      float o2 = v[j].z * rstd * gg.z * (1.f + c4.z) + s4.z;
      float o3 = v[j].w * rstd * gg.w * (1.f + c4.w) + s4.w;
      *(uint2*)(A + (size_t)m * DM + c) = make_uint2(pk2(o0, o1), pk2(o2, o3));
    }
  };
#pragma unroll 1
  for (int m = vbid() * 4 + w; m < MROWS; m += 2 * nw) {
    const int m2 = m + nw;
    float4 va[4], vb[4];
    load_row(m, va);
    if (m2 < MROWS) load_row(m2, vb);
    finish_row(m, va);
    if (m2 < MROWS) finish_row(m2, vb);
  }
}

DEVI void phase_final(const Params& P) {
  const int tid = otid(), w = tid >> 6, lane = tid & 63;
  const float* g = P.in[I_GF];
  const int nw = nvb() * 4;
  auto load_row = [&](int m, float4 (&v)[4]) {
    const float* hr = P.out + (size_t)m * DM;
#pragma unroll
    for (int j = 0; j < 4; ++j) v[j] = *(const float4*)(hr + j * 256 + lane * 4);
  };
  auto finish_row = [&](int m, const float4 (&v)[4]) {
    float* hr = P.out + (size_t)m * DM;
    float ss = 0.f;
#pragma unroll
    for (int j = 0; j < 4; ++j) ss += v[j].x * v[j].x + v[j].y * v[j].y + v[j].z * v[j].z + v[j].w * v[j].w;
    ss = wave_sum(ss);
    float rstd = rsqrtf(ss * (1.f / 1024.f) + 1e-6f);
#pragma unroll
    for (int j = 0; j < 4; ++j) {
      int c = j * 256 + lane * 4;
      float4 gg = *(const float4*)(g + c);
      float4 o = make_float4(v[j].x * rstd * gg.x, v[j].y * rstd * gg.y, v[j].z * rstd * gg.z, v[j].w * rstd * gg.w);
      *(float4*)(hr + c) = o;
    }
  };
#pragma unroll 1
  for (int m = vbid() * 4 + w; m < 2 * SEQ; m += 2 * nw) {
    const int m2 = m + nw;
    float4 va[4], vb[4];
    load_row(m, va);
    if (m2 < 2 * SEQ) load_row(m2, vb);
    finish_row(m, va);
    if (m2 < 2 * SEQ) finish_row(m2, vb);
  }
}

constexpr int LDT = 72;
DEVI float sumsq8(bf16x8 v) {
  uint4 u = __builtin_bit_cast(uint4, v);
  float a = bflo(u.x), b = bfhi(u.x), c = bflo(u.y), d = bfhi(u.y), e = bflo(u.z), f = bfhi(u.z), g = bflo(u.w), h = bfhi(u.w);
  return a * a + b * b + c * c + d * d + e * e + f * f + g * g + h * h;
}
template <bool ROWNORM = false, class Epi>
DEVI void gemm_tile(const bf16_t* __restrict__ A, int lda, const bf16_t* __restrict__ Bt, int ldb, int K, int m0, int n0, bf16_t* smem, Epi epi) {
  bf16_t* As = smem;
  bf16_t* Bs = smem + 2 * 128 * LDT;
  const int tid = otid(), lane = tid & 63, w = tid >> 6;
  const int wm = w & 1, wn = w >> 1;
  f32x4 acc[4][4];
#pragma unroll
  for (int i = 0; i < 4; ++i)
#pragma unroll
    for (int j = 0; j < 4; ++j) acc[i][j] = (f32x4){0.f, 0.f, 0.f, 0.f};
  const int lrow = tid >> 3, lkc = (tid & 7) * 8;
  const bf16_t* ag = A + (size_t)(m0 + lrow) * lda + lkc;
  const bf16_t* bg = Bt + (size_t)(n0 + lrow) * ldb + lkc;
  u32x4 ra0[4], ra1[4], rb0[4];
  const int nk = K / 64;
  const int fr = lane & 15, fq = (lane >> 4) * 8;
  float ssq[4] = {0.f, 0.f, 0.f, 0.f};
#pragma unroll
  for (int i = 0; i < 4; ++i) {
    ra0[i] = *(const u32x4*)(ag + (size_t)(32 * i) * lda);
    rb0[i] = *(const u32x4*)(bg + (size_t)(32 * i) * ldb);
    ra1[i] = *(const u32x4*)(ag + (size_t)(32 * i) * lda + 64);
  }
  auto kstep = [&](int kt, int buf, u32x4 (&ra)[4]) {
    u32x4 (&rb)[4] = rb0;
    bf16_t* as = As + buf * 128 * LDT;
    bf16_t* bs = Bs + buf * 128 * LDT;
#pragma unroll
    for (int i = 0; i < 4; ++i) {
      *(u32x4*)(as + (lrow + 32 * i) * LDT + lkc) = ra[i];
      *(u32x4*)(bs + (lrow + 32 * i) * LDT + lkc) = rb[i];
    }
    __syncthreads();
    if (kt + 2 < nk) {
#pragma unroll
      for (int i = 0; i < 4; ++i) ra[i] = *(const u32x4*)(ag + (size_t)(32 * i) * lda + (kt + 2) * 64);
    }
    if (kt + 1 < nk) {
#pragma unroll
      for (int i = 0; i < 4; ++i) rb[i] = *(const u32x4*)(bg + (size_t)(32 * i) * ldb + (kt + 1) * 64);
    }
#pragma unroll
    for (int ks = 0; ks < 2; ++ks) {
      bf16x8 af[4], bfr[4];
#pragma unroll
      for (int i = 0; i < 4; ++i) {
        af[i] = *(const bf16x8*)(as + (wm * 64 + i * 16 + fr) * LDT + ks * 32 + fq);
        bfr[i] = *(const bf16x8*)(bs + (wn * 64 + i * 16 + fr) * LDT + ks * 32 + fq);
        if (ROWNORM) ssq[i] += sumsq8(af[i]);
      }
#pragma unroll
      for (int i = 0; i < 4; ++i)
#pragma unroll
        for (int j = 0; j < 4; ++j) acc[i][j] = mfma16(bfr[j], af[i], acc[i][j]);
    }
  };
#pragma unroll 1
  for (int kt = 0; kt < nk; kt += 2) {
    kstep(kt, 0, ra0);
    kstep(kt + 1, 1, ra1);
  }
  __syncthreads();
#pragma unroll
  for (int i = 0; i < 4; ++i)
#pragma unroll
    for (int j = 0; j < 4; ++j) {
      int m = m0 + wm * 64 + i * 16 + fr;
      int n = n0 + wn * 64 + j * 16 + (lane >> 4) * 4;
      if (ROWNORM) {
        float t = ssq[i]; t += __shfl_xor(t, 16); t += __shfl_xor(t, 32);
        epi(m, n, acc[i][j] * rsqrtf(t / (float)K + 1e-6f));
      } else epi(m, n, acc[i][j]);
    }
}

DEVI void phase_prep(const Params& P, int l, unsigned char* smem) {
  const int tid = otid(), w = tid >> 6, lane = tid & 63;
  bf16_t* Pm = (bf16_t*)(P.ws + OFF_P);
  const float2* rs_swa = (const float2*)(P.ws + OFF_ROPE);
  const float2* rs_mla = (const float2*)(P.ws + OFF_ROPE + 16384);
  const float* convw = P.in[I_CONVW] + (size_t)l * 5 * 768;
  const float* convb = P.in[I_CONVB] + (size_t)l * 768;
  const float* gq = P.in[I_GQ] + l * 256;
  const float* gkv = P.in[I_GKV] + l * 128;
  const int gthreads = nvb() * 256, gt0 = vbid() * 256 + tid;
  for (int idx = gt0; idx < MROWS * 24; idx += gthreads) {
    int row = idx / 24, rem = idx - row * 24;
    int b = row / TOK, t = row - b * TOK;
    if (t < LCTX) continue;
    int hs = rem >> 2, half = (rem >> 1) & 1, j = rem & 1;
    int li = t - LCTX;
    int pos = half ? (li & 63) : (li >> 6);
    const float4* cp = (const float4*)(rs_swa + pos * 16 + j * 8);
    float4 c01 = cp[0], c23 = cp[1], c45 = cp[2], c67 = cp[3];
    bf16_t* bp = Pm + (size_t)row * PP + (hs < 4 ? C_SWQ + hs * 64 : C_SWK + (hs - 4) * 64) + half * 32 + j * 8;
    uint4 x1 = *(const uint4*)bp, x2 = *(const uint4*)(bp + 16);
    uint4 y1, y2;
    y1.x = pk2(bflo(x1.x) * c01.x - bflo(x2.x) * c01.y, bfhi(x1.x) * c01.z - bfhi(x2.x) * c01.w);
    y2.x = pk2(bflo(x2.x) * c01.x + bflo(x1.x) * c01.y, bfhi(x2.x) * c01.z + bfhi(x1.x) * c01.w);
    y1.y = pk2(bflo(x1.y) * c23.x - bflo(x2.y) * c23.y, bfhi(x1.y) * c23.z - bfhi(x2.y) * c23.w);
    y2.y = pk2(bflo(x2.y) * c23.x + bflo(x1.y) * c23.y, bfhi(x2.y) * c23.z + bfhi(x1.y) * c23.w);
    y1.z = pk2(bflo(x1.z) * c45.x - bflo(x2.z) * c45.y, bfhi(x1.z) * c45.z - bfhi(x2.z) * c45.w);
    y2.z = pk2(bflo(x2.z) * c45.x + bflo(x1.z) * c45.y, bfhi(x2.z) * c45.z + bfhi(x1.z) * c45.w);
    y1.w = pk2(bflo(x1.w) * c67.x - bflo(x2.w) * c67.y, bfhi(x1.w) * c67.z - bfhi(x2.w) * c67.w);
    y2.w = pk2(bflo(x2.w) * c67.x + bflo(x1.w) * c67.y, bfhi(x2.w) * c67.z + bfhi(x1.w) * c67.w);
    *(uint4*)bp = y1;
    *(uint4*)(bp + 16) = y2;
  }
  {
    bf16_t* tv = (bf16_t*)smem;
    for (int u = vbid(); u < 264 * 6; u += nvb()) {
      const int tt = u / 6, ct = u - tt * 6;
      const int r0 = tt * 64;
      const int b = r0 / TOK, tb = r0 - b * TOK;
      const int col = ct < 4 ? C_NAV + ct * 64 : C_SWV + (ct - 4) * 64;
      for (int c = tid; c < 512; c += 256) {
        int rr = c >> 3, part = c & 7;
        *(uint4*)(tv + rr * 72 + part * 8) = *(const uint4*)(Pm + (size_t)(r0 + rr) * PP + col + part * 8);
      }
      __syncthreads();
      bf16_t* dstb = ct < 4 ? (bf16_t*)(P.ws + OFF_VTNA) + (size_t)(b * 256 + ct * 64) * TOK + tb
                            : (bf16_t*)(P.ws + OFF_VTSWA) + (size_t)(b * 128 + (ct - 4) * 64) * TOK + tb;
      for (int c = tid; c < 512; c += 256) {
        int chl = c >> 3, part = c & 7, g16 = part >> 1, hh = part & 1;
        const bf16_t* tp = tv + (g16 * 16 + 4 * hh) * 72 + chl;
        uint4 ov = make_uint4((unsigned)tp[0] | ((unsigned)tp[72] << 16), (unsigned)tp[2 * 72] | ((unsigned)tp[3 * 72] << 16),
                              (unsigned)tp[8 * 72] | ((unsigned)tp[9 * 72] << 16), (unsigned)tp[10 * 72] | ((unsigned)tp[11 * 72] << 16));
        *(uint4*)(dstb + (size_t)chl * TOK + g16 * 16 + hh * 8) = ov;
      }
      __syncthreads();
    }
  }
  {
    const int nw = nvb() * 4;
#pragma unroll 1
    for (int rowi = vbid() * 4 + w; rowi < MROWS; rowi += nw) {
      int b = rowi / TOK, t = rowi - b * TOK;
      if (t >= LCTX && lane < 16) {
        bf16_t* row = Pm + (size_t)rowi * PP;
        int half = lane >> 3, ii = lane & 7;
        int li = t - LCTX;
        int pos = half ? (li & 63) : (li >> 6);
        float2 cs = rs_mla[pos * 8 + ii];
        bf16_t* bp = row + C_MKR + half * 16 + ii;
        float x1 = bf2f(bp[0]), x2 = bf2f(bp[8]);
        bp[0] = f2bf(x1 * cs.x - x2 * cs.y);
        bp[8] = f2bf(x2 * cs.x + x1 * cs.y);
      }
    }
  }
  {
    bf16_t* XBC = (bf16_t*)(P.ws + OFF_XBC);
    bf16_t* XBCT = (bf16_t*)(P.ws + OFF_XBCT);
    bf16_t* tin = (bf16_t*)smem;
    bf16_t* tout = tin + 68 * 72;
    float* wl = (float*)(tout + 64 * 72);
    for (int u = vbid(); u < 264 * 12; u += nvb()) {
      const int tt = u / 12, ct = u - tt * 12;
      const int r0 = tt * 64, ch0 = ct * 64;
      const int b = r0 / TOK, tb = r0 - b * TOK;
      const bool isctx = tb < LCTX;
      const int seg_lo = isctx ? 0 : LCTX, seg_hi = isctx ? LCTX : TOK;
      for (int c = tid; c < 68 * 8; c += 256) {
        int rr = c >> 3, part = c & 7;
        int tk = tb - 2 + rr;
        uint4 v = make_uint4(0u, 0u, 0u, 0u);
        if (tk >= seg_lo && tk < seg_hi) v = *(const uint4*)(Pm + (size_t)(b * TOK + tk) * PP + C_SX + ch0 + part * 8);
        *(uint4*)(tin + rr * 72 + part * 8) = v;
      }
      for (int c = tid; c < 384; c += 256) wl[c] = c < 320 ? convw[(c >> 6) * 768 + ch0 + (c & 63)] : convb[ch0 + c - 320];
      __syncthreads();
      {
        const int tok = tid & 63, cg = tid >> 6;
        float acc[16];
#pragma unroll
        for (int c = 0; c < 16; ++c) acc[c] = 0.f;
#pragma unroll
        for (int k = 0; k < 5; ++k) {
          const uint4 a = *(const uint4*)(tin + (tok + k) * 72 + cg * 16);
          const uint4 a2 = *(const uint4*)(tin + (tok + k) * 72 + cg * 16 + 8);
          const float* wk = wl + k * 64 + cg * 16;
          acc[0] += bflo(a.x) * wk[0]; acc[1] += bfhi(a.x) * wk[1]; acc[2] += bflo(a.y) * wk[2]; acc[3] += bfhi(a.y) * wk[3];
          acc[4] += bflo(a.z) * wk[4]; acc[5] += bfhi(a.z) * wk[5]; acc[6] += bflo(a.w) * wk[6]; acc[7] += bfhi(a.w) * wk[7];
          acc[8] += bflo(a2.x) * wk[8]; acc[9] += bfhi(a2.x) * wk[9]; acc[10] += bflo(a2.y) * wk[10]; acc[11] += bfhi(a2.y) * wk[11];
          acc[12] += bflo(a2.z) * wk[12]; acc[13] += bfhi(a2.z) * wk[13]; acc[14] += bflo(a2.w) * wk[14]; acc[15] += bfhi(a2.w) * wk[15];
        }
        const float* bk = wl + 320 + cg * 16;
#pragma unroll
        for (int c = 0; c < 16; ++c) acc[c] = siluf(acc[c] + bk[c]);
        *(uint4*)(tout + tok * 72 + cg * 16) = make_uint4(pk2(acc[0], acc[1]), pk2(acc[2], acc[3]), pk2(acc[4], acc[5]), pk2(acc[6], acc[7]));
        *(uint4*)(tout + tok * 72 + cg * 16 + 8) = make_uint4(pk2(acc[8], acc[9]), pk2(acc[10], acc[11]), pk2(acc[12], acc[13]), pk2(acc[14], acc[15]));
      }
      __syncthreads();
      for (int c = tid; c < 512; c += 256) {
        int rr = c >> 3, part = c & 7;
        *(uint4*)(XBC + (size_t)(r0 + rr) * 768 + ch0 + part * 8) = *(const uint4*)(tout + rr * 72 + part * 8);
      }
      if (ch0 < 512) {
        for (int c = tid; c < 512; c += 256) {
          int chl = c >> 3, part = c & 7;
          const bf16_t* tp = tout + (part * 8) * 72 + chl;
          uint4 ov = make_uint4((unsigned)tp[0] | ((unsigned)tp[72] << 16), (unsigned)tp[2 * 72] | ((unsigned)tp[3 * 72] << 16),
                                (unsigned)tp[4 * 72] | ((unsigned)tp[5 * 72] << 16), (unsigned)tp[6 * 72] | ((unsigned)tp[7 * 72] << 16));
          *(uint4*)(XBCT + (size_t)(b * 512 + ch0 + chl) * TOK + tb + part * 8) = ov;
        }
      }
      __syncthreads();
    }
  }
}

template <int MODE>
DEVI void flash_unit(const Params& P, int l, int b, int h, int qctx, int qi0) {
  const int lane = otid() & 63, q = lane & 31, hi = lane >> 5;
  const bf16_t* Pb = (const bf16_t*)(P.ws + OFF_P) + (size_t)b * TOK * PP;
  const int qt = (qctx ? 0 : LCTX) + qi0 + q;
  const int li = qi0 + q;
  const bf16_t* K1;
  const bf16_t* Vt;
  int ocol;
  const float sc2 = 0.125f * LOG2E;
  bf16x8 qop[4];
  if (MODE == 0) {
    const bf16_t* qs = Pb + (size_t)qt * PP + C_NAQ + h * 64 + hi * 8;
#pragma unroll
    for (int s = 0; s < 4; ++s) qop[s] = ld8(qs + 16 * s);
    K1 = Pb + C_NAK + h * 64;
    Vt = (const bf16_t*)(P.ws + OFF_VTNA) + (size_t)(b * 256 + h * 64) * TOK;
    ocol = h * 64;
  } else {
    const bf16_t* qs = Pb + (size_t)qt * PP + C_SWQ + h * 64 + hi * 8;
#pragma unroll
    for (int s = 0; s < 4; ++s) qop[s] = ld8(qs + 16 * s);
    K1 = Pb + C_SWK + (h >> 1) * 64;
    Vt = (const bf16_t*)(P.ws + OFF_VTSWA) + (size_t)(b * 128 + (h >> 1) * 64) * TOK;
    ocol = 256 + h * 64;
  }
  float m = -1e30f, lsum = 0.f;
  if (MODE == 1) {
    m = P.in[I_SINK][l * 4 + h] * LOG2E;
    lsum = hi ? 0.f : 1.f;
  }
  f32x16 o0, o1;
#pragma unroll
  for (int i = 0; i < 16; ++i) { o0[i] = 0.f; o1[i] = 0.f; }
  const int nr = li >> 6, qc = li & 63;
  int rs = nr - 4; rs = rs < 0 ? 0 : (rs > 120 ? 120 : rs);
  int cs = qc - 8; cs = cs < 0 ? 0 : (cs > 48 ? 48 : cs);
  const float* rpb = P.in[I_RPB] + (size_t)(l * 4 + h) * 15 * 31;
  const int qb = qi0 >> 5;
  const int nlo = (4 - qb) > 0 ? (4 - qb) : 0;
  const int nhi = (260 - qb) < 9 ? (260 - qb) : 9;
  const int nblk = qctx ? 8 : (MODE == 0 ? 24 : 8 + nhi - nlo);
  auto kt0_of = [&](int blk) -> int {
    if (blk < 8) return blk * 32;
    if (MODE == 0) { int idx = blk - 8; return LCTX + (rs + (idx >> 1)) * 64 + (idx & 1) * 32; }
    return LCTX + qi0 - 128 + 32 * (nlo + blk - 8);
  };
  bf16x8 kc[4];
  {
    const bf16_t* kp = K1 + (size_t)(kt0_of(0) + q) * PP + hi * 8;
#pragma unroll
    for (int s = 0; s < 4; ++s) kc[s] = ld8(kp + 16 * s);
  }
#pragma unroll 1
  for (int blk = 0; blk < nblk; ++blk) {
    const int kt0 = kt0_of(blk);
    const bf16_t* vp = Vt + (size_t)q * TOK + kt0 + 8 * hi;
    bf16x8 v00 = ld8(vp), v01 = ld8(vp + 16), v10 = ld8(vp + (size_t)32 * TOK), v11 = ld8(vp + (size_t)32 * TOK + 16);
    bf16x8 kn[4];
    {
      const int nb = (blk + 1 < nblk) ? blk + 1 : blk;
      const bf16_t* kp = K1 + (size_t)(kt0_of(nb) + q) * PP + hi * 8;
#pragma unroll
      for (int s = 0; s < 4; ++s) kn[s] = ld8(kp + 16 * s);
    }
    f32x16 st;
#pragma unroll
    for (int i = 0; i < 16; ++i) st[i] = 0.f;
#pragma unroll
    for (int s = 0; s < 4; ++s) st = mfma32(kc[s], qop[s], st);
    float sc[16];
#pragma unroll
    for (int i = 0; i < 16; ++i) sc[i] = st[i] * sc2;
    if (blk >= 8) {
      if (MODE == 0) {
        const int idx = blk - 8, kr = rs + (idx >> 1), cb = idx & 1;
        const float* rp = rpb + (kr - nr + 7) * 31;
#pragma unroll
        for (int i = 0; i < 16; ++i) {
          int kcol = cb * 32 + 8 * (i >> 2) + 4 * hi + (i & 3);
          int dc = kcol - qc + 15; dc = dc < 0 ? 0 : (dc > 30 ? 30 : dc);
          bool valid = (kcol >= cs) && (kcol < cs + 16);
          sc[i] = valid ? sc[i] + rp[dc] * LOG2E : -INFINITY;
        }
      } else {
        const int js = kt0 - LCTX;
#pragma unroll
        for (int i = 0; i < 16; ++i) {
          int j = js + 8 * (i >> 2) + 4 * hi + (i & 3);
          int d = li - j; d = d < 0 ? -d : d;
          sc[i] = (d <= 128) ? sc[i] : -INFINITY;
        }
      }
    }
    float mx = sc[0];
#pragma unroll
    for (int i = 1; i < 16; ++i) mx = fmaxf(mx, sc[i]);
    mx = fmaxf(mx, __shfl_xor(mx, 32));
    float mn = fmaxf(m, mx);
    float alpha = ex2(m - mn);
    m = mn;
    float ps = 0.f;
#pragma unroll
    for (int i = 0; i < 16; ++i) { sc[i] = ex2(sc[i] - mn); ps += sc[i]; }
    lsum = lsum * alpha + ps;
#pragma unroll
    for (int i = 0; i < 16; ++i) { o0[i] *= alpha; o1[i] *= alpha; }
    bf16x8 p0 = mk8(pk2(sc[0], sc[1]), pk2(sc[2], sc[3]), pk2(sc[4], sc[5]), pk2(sc[6], sc[7]));
    bf16x8 p1 = mk8(pk2(sc[8], sc[9]), pk2(sc[10], sc[11]), pk2(sc[12], sc[13]), pk2(sc[14], sc[15]));
    o0 = mfma32(v00, p0, o0);
    o0 = mfma32(v01, p1, o0);
    o1 = mfma32(v10, p0, o1);
    o1 = mfma32(v11, p1, o1);
#pragma unroll
    for (int s = 0; s < 4; ++s) kc[s] = kn[s];
  }
  float lt = lsum + __shfl_xor(lsum, 32);
  float inv = 1.f / lt;
  bf16_t* op = (bf16_t*)(P.ws + OFF_A) + (size_t)(b * TOK + qt) * DM + ocol + 4 * hi;
#pragma unroll
  for (int i4 = 0; i4 < 4; ++i4) {
    *(uint2*)(op + 8 * i4) = make_uint2(pk2(o0[4 * i4] * inv, o0[4 * i4 + 1] * inv), pk2(o0[4 * i4 + 2] * inv, o0[4 * i4 + 3] * inv));
    *(uint2*)(op + 32 + 8 * i4) = make_uint2(pk2(o1[4 * i4] * inv, o1[4 * i4 + 1] * inv), pk2(o1[4 * i4 + 2] * inv, o1[4 * i4 + 3] * inv));
  }
}

typedef __attribute__((address_space(3))) unsigned lds_u32;
struct HalfBar { lds_u32* cnt; unsigned tgt; };
DEVI void half_barrier(HalfBar& hb) {
  hb.tgt += 4u;
  asm volatile("s_waitcnt lgkmcnt(0)" ::: "memory");
  if ((threadIdx.x & 63) == 0) __hip_atomic_fetch_add(hb.cnt, 1u, __ATOMIC_RELEASE, __HIP_MEMORY_SCOPE_WORKGROUP);
  while (__hip_atomic_load(hb.cnt, __ATOMIC_ACQUIRE, __HIP_MEMORY_SCOPE_WORKGROUP) < hb.tgt) __builtin_amdgcn_s_sleep(1);
  asm volatile("" ::: "memory");
}

constexpr int KLD = 104, VLD = 72;
DEVI void mla_block(const Params& P, int l, int b, int h, int qctx, int qb0, unsigned char* smem, HalfBar& hb) {
  const int tid = otid(), lane = tid & 63, w = tid >> 6, q = lane & 31, hi = lane >> 5;
  bf16_t* Kl = (bf16_t*)smem;
  const int qi0 = qb0 + w * 32;
  const int qt = (qctx ? 0 : LCTX) + qi0 + q;
  const int li = qi0 + q;
  const float sc2 = 0.10206207261596577f * LOG2E;
  bf16x8 qop[6];
  {
    const bf16_t* qs = (const bf16_t*)(P.ws + OFF_MQ) + (size_t)(b * TOK + qt) * 384 + h * 96 + hi * 8;
    const float2* rs_mla = (const float2*)(P.ws + OFF_ROPE + 16384);
#pragma unroll
    for (int s = 0; s < 6; ++s) {
      uint4 own = *(const uint4*)(qs + 16 * s);
      float f0 = bflo(own.x), f1 = bfhi(own.x), f2 = bflo(own.y), f3 = bfhi(own.y), f4 = bflo(own.z), f5 = bfhi(own.z), f6 = bflo(own.w), f7 = bfhi(own.w);
      if (s >= 4 && !qctx) {
        int pos = (s == 4) ? (li >> 6) : (li & 63);
        uint4 oth;
        oth.x = __shfl_xor((int)own.x, 32); oth.y = __shfl_xor((int)own.y, 32);
        oth.z = __shfl_xor((int)own.z, 32); oth.w = __shfl_xor((int)own.w, 32);
        float sg = hi ? 1.f : -1.f;
        const float2* cp = rs_mla + pos * 8;
        float2 c0 = cp[0], c1 = cp[1], c2 = cp[2], c3 = cp[3], c4 = cp[4], c5 = cp[5], c6 = cp[6], c7 = cp[7];
        f0 = f0 * c0.x + sg * bflo(oth.x) * c0.y; f1 = f1 * c1.x + sg * bfhi(oth.x) * c1.y;
        f2 = f2 * c2.x + sg * bflo(oth.y) * c2.y; f3 = f3 * c3.x + sg * bfhi(oth.y) * c3.y;
        f4 = f4 * c4.x + sg * bflo(oth.z) * c4.y; f5 = f5 * c5.x + sg * bfhi(oth.z) * c5.y;
        f6 = f6 * c6.x + sg * bflo(oth.w) * c6.y; f7 = f7 * c7.x + sg * bfhi(oth.w) * c7.y;
      }
      qop[s] = mk8(pk2(f0 * sc2, f1 * sc2), pk2(f2 * sc2, f3 * sc2), pk2(f4 * sc2, f5 * sc2), pk2(f6 * sc2, f7 * sc2));
    }
  }
  const bf16_t* MKb = (const bf16_t*)(P.ws + OFF_MK) + (size_t)b * TOK * 256 + h * 64;
  const bf16_t* KRb = (const bf16_t*)(P.ws + OFF_P) + (size_t)b * TOK * PP + C_MKR;
  const bf16_t* VTb = (const bf16_t*)(P.ws + OFF_VTMLA) + (size_t)(b * 256 + h * 64) * TOK;
  const int nt = qctx ? 4 : 132;
  const int kk = tid >> 3, kpart = (tid & 7) * 8;
  const int rk = tid >> 2, rpart = (tid & 3) * 8;
  constexpr int BUFE = 64 * (KLD + VLD);
  u32x4 gk0, gk1, gr, gv0, gv1;
  auto gload = [&](int t) {
    const int kt0 = t * 64;
    gk0 = *(const u32x4*)(MKb + (size_t)(kt0 + kk) * 256 + kpart);
    gk1 = *(const u32x4*)(MKb + (size_t)(kt0 + kk + 32) * 256 + kpart);
    gr = *(const u32x4*)(KRb + (size_t)(kt0 + rk) * PP + rpart);
    gv0 = *(const u32x4*)(VTb + (size_t)kk * TOK + kt0 + kpart);
    gv1 = *(const u32x4*)(VTb + (size_t)(kk + 32) * TOK + kt0 + kpart);
  };
  auto lstore = [&](int buf) {
    bf16_t* kl = Kl + buf * BUFE;
    bf16_t* vl = kl + 64 * KLD;
    *(u32x4*)(kl + kk * KLD + kpart) = gk0;
    *(u32x4*)(kl + (kk + 32) * KLD + kpart) = gk1;
    *(u32x4*)(kl + rk * KLD + 64 + rpart) = gr;
    *(u32x4*)(vl + kk * VLD + kpart) = gv0;
    *(u32x4*)(vl + (kk + 32) * VLD + kpart) = gv1;
  };
  float m = 0.f, lsum = 0.f;
  f32x16 o0, o1, sA0, sA1, sB0, sB1;
#pragma unroll
  for (int i = 0; i < 16; ++i) { o0[i] = 0.f; o1[i] = 0.f; }
  auto step = [&](bool PREV, bool CUR, bool first, int bc, int bp, f32x16& p0, f32x16& p1, f32x16& c0, f32x16& c1) {
    bf16x8 kx[6], va[4], vb[4];
    const bf16_t* kl = Kl + bc * BUFE + q * KLD + hi * 8;
    if (CUR) {
#pragma unroll
      for (int s = 0; s < 6; ++s) kx[s] = *(const bf16x8*)(kl + 16 * s);
    }
    if (PREV) {
      float mx = max3f(p0[0], p1[0], p0[1]);
      mx = max3f(mx, p1[1], p0[2]); mx = max3f(mx, p1[2], p0[3]); mx = max3f(mx, p1[3], p0[4]); mx = max3f(mx, p1[4], p0[5]);
      mx = max3f(mx, p1[5], p0[6]); mx = max3f(mx, p1[6], p0[7]); mx = max3f(mx, p1[7], p0[8]); mx = max3f(mx, p1[8], p0[9]);
      mx = max3f(mx, p1[9], p0[10]); mx = max3f(mx, p1[10], p0[11]); mx = max3f(mx, p1[11], p0[12]); mx = max3f(mx, p1[12], p0[13]);
      mx = max3f(mx, p1[13], p0[14]); mx = max3f(mx, p1[14], p0[15]); mx = max3f(mx, p1[15], mx);
      if (__any(mx > 8.f) || first) {
        mx = fmaxf(mx, __shfl_xor(mx, 32));
        float d = first ? mx : fmaxf(mx, 0.f);
        m += d;
        float alpha = ex2(-d);
        lsum *= alpha;
#pragma unroll
        for (int i = 0; i < 16; ++i) { o0[i] *= alpha; o1[i] *= alpha; p0[i] -= d; p1[i] -= d; }
      }
    }
    float ps = 0.f;
    if (CUR) {
      const float negm = -m;
#pragma unroll
      for (int i = 0; i < 16; ++i) c0[i] = negm;
#pragma unroll
      for (int s = 0; s < 6; ++s) c0 = mfma32(kx[s], qop[s], c0);
    }
    if (PREV) {
#pragma unroll
      for (int i = 0; i < 16; ++i) { p0[i] = ex2(p0[i]); ps += p0[i]; }
    }
    __builtin_amdgcn_sched_barrier(0);
    if (CUR) {
#pragma unroll
      for (int s = 0; s < 6; ++s) kx[s] = *(const bf16x8*)(kl + 32 * KLD + 16 * s);
      const float negm = -m;
#pragma unroll
      for (int i = 0; i < 16; ++i) c1[i] = negm;
#pragma unroll
      for (int s = 0; s < 6; ++s) c1 = mfma32(kx[s], qop[s], c1);
    }
    if (PREV) {
      const bf16_t* vl = Kl + bp * BUFE + 64 * KLD + q * VLD + hi * 8;
#pragma unroll
      for (int s = 0; s < 4; ++s) { va[s] = *(const bf16x8*)(vl + 16 * s); vb[s] = *(const bf16x8*)(vl + 32 * VLD + 16 * s); }
#pragma unroll
      for (int i = 0; i < 16; ++i) { p1[i] = ex2(p1[i]); ps += p1[i]; }
      lsum += ps;
      bf16x8 pa0 = mk8(pk2(p0[0], p0[1]), pk2(p0[2], p0[3]), pk2(p0[4], p0[5]), pk2(p0[6], p0[7]));
      bf16x8 pa1 = mk8(pk2(p0[8], p0[9]), pk2(p0[10], p0[11]), pk2(p0[12], p0[13]), pk2(p0[14], p0[15]));
      bf16x8 pb0 = mk8(pk2(p1[0], p1[1]), pk2(p1[2], p1[3]), pk2(p1[4], p1[5]), pk2(p1[6], p1[7]));
      bf16x8 pb1 = mk8(pk2(p1[8], p1[9]), pk2(p1[10], p1[11]), pk2(p1[12], p1[13]), pk2(p1[14], p1[15]));
      o0 = mfma32(va[0], pa0, o0);
      o1 = mfma32(vb[0], pa0, o1);
      o0 = mfma32(va[1], pa1, o0);
      o1 = mfma32(vb[1], pa1, o1);
      o0 = mfma32(va[2], pb0, o0);
      o1 = mfma32(vb[2], pb0, o1);
      o0 = mfma32(va[3], pb1, o0);
      o1 = mfma32(vb[3], pb1, o1);
    }
  };
  __builtin_amdgcn_s_setprio(1);
  half_barrier(hb);
  gload(0);
  lstore(0);
  half_barrier(hb);
  gload(1);
  step(false, true, false, 0, 0, sA0, sA1, sA0, sA1);
  lstore(1);
  half_barrier(hb);
  int bp = 0, bc = 1;
  int t = 1;
#pragma unroll 1
  for (; t + 1 < nt; t += 2) {
    {
      const int bn = bc == 2 ? 0 : bc + 1;
      gload(t + 1);
      step(true, true, t == 1, bc, bp, sA0, sA1, sB0, sB1);
      lstore(bn);
      bp = bc; bc = bn;
      half_barrier(hb);
    }
    {
      const int bn = bc == 2 ? 0 : bc + 1;
      if (t + 2 < nt) gload(t + 2);
      step(true, true, false, bc, bp, sB0, sB1, sA0, sA1);
      if (t + 2 < nt) lstore(bn);
      bp = bc; bc = bn;
      half_barrier(hb);
    }
  }
  step(true, true, false, bc, bp, sA0, sA1, sB0, sB1);
  step(true, false, false, bc, bc, sB0, sB1, sB0, sB1);
  __builtin_amdgcn_s_setprio(0);
  float lt = lsum + __shfl_xor(lsum, 32);
  float inv = 1.f / lt;
  bf16_t* op = (bf16_t*)(P.ws + OFF_A) + (size_t)(b * TOK + qt) * DM + 512 + h * 64 + 4 * hi;
#pragma unroll
  for (int i4 = 0; i4 < 4; ++i4) {
    *(uint2*)(op + 8 * i4) = make_uint2(pk2(o0[4 * i4] * inv, o0[4 * i4 + 1] * inv), pk2(o0[4 * i4 + 2] * inv, o0[4 * i4 + 3] * inv));
    *(uint2*)(op + 32 + 8 * i4) = make_uint2(pk2(o1[4 * i4] * inv, o1[4 * i4 + 1] * inv), pk2(o1[4 * i4 + 2] * inv, o1[4 * i4 + 3] * inv));
  }
}

DEVI void ssd_s1_unit(const Params& P, int l, int cgk, int h, float* smem, HalfBar& hb) {
  const int tid = otid(), w = tid >> 6, lane = tid & 63, q = lane & 31, hi = lane >> 5;
  const int b = cgk / 66, c = cgk - b * 66;
  const int t0 = c * 128, r0 = cgk * 128;
  const int g = h >> 1;
  float* wj = smem;
  const bf16_t* Pm = (const bf16_t*)(P.ws + OFF_P);
  if (w < 2) {
    const int dir = w;
    const float bias = P.in[I_DTB][l * 8 + dir * 4 + h];
    const float a = -__expf(P.in[I_ALOG][l * 8 + dir * 4 + h]);
    float raw0 = bf2f(Pm[(size_t)(r0 + 2 * lane) * PP + C_SDT + dir * 4 + h]) + bias;
    float raw1 = bf2f(Pm[(size_t)(r0 + 2 * lane + 1) * PP + C_SDT + dir * 4 + h]) + bias;
    float dt0 = softplusf(raw0);
    float dt1 = softplusf(raw1);
    float v0 = dt0 * a, v1 = dt1 * a;
    float s = v0 + v1;
    float inc = s;
#pragma unroll
    for (int o = 1; o < 64; o <<= 1) {
      float t = __shfl_up(inc, o);
      if (lane >= o) inc += t;
    }
    float T = __int_as_float(__builtin_amdgcn_readlane(__float_as_int(inc), 63));
    float exc = inc - s;
    float L0, L1;
    if (dir == 0) { L0 = exc + v0; L1 = exc + s; }
    else { L0 = T - exc; L1 = T - exc - v0; }
    float* DT = (float*)(P.ws + OFF_DT);
    float* LL = (float*)(P.ws + OFF_L);
    DT[(size_t)(r0 + 2 * lane) * 8 + dir * 4 + h] = dt0;
    DT[(size_t)(r0 + 2 * lane + 1) * 8 + dir * 4 + h] = dt1;
    LL[(size_t)(r0 + 2 * lane) * 8 + dir * 4 + h] = L0;
    LL[(size_t)(r0 + 2 * lane + 1) * 8 + dir * 4 + h] = L1;
    wj[dir * 128 + 2 * lane] = dt0 * __expf(T - L0);
    wj[dir * 128 + 2 * lane + 1] = dt1 * __expf(T - L1);
    if (lane == 0) ((float*)(P.ws + OFF_CD))[cgk * 8 + dir * 4 + h] = __expf(T);
  }
  half_barrier(hb);
  const bf16_t* XT = (const bf16_t*)(P.ws + OFF_XBCT) + (size_t)b * 512 * TOK + t0;
  const bf16_t* xr0 = XT + (size_t)(h * 64 + q) * TOK + hi * 8;
  const bf16_t* xr1 = xr0 + (size_t)32 * TOK;
  const bf16_t* br = XT + (size_t)(256 + g * 128 + w * 32 + q) * TOK + hi * 8;
  f32x16 acc[2][2];
#pragma unroll
  for (int d = 0; d < 2; ++d)
#pragma unroll
    for (int mt = 0; mt < 2; ++mt)
#pragma unroll
      for (int i = 0; i < 16; ++i) acc[d][mt][i] = 0.f;
#pragma unroll 2
  for (int ks = 0; ks < 8; ++ks) {
    bf16x8 bop = ld8(br + 16 * ks);
    uint4 x0 = *(const uint4*)(xr0 + 16 * ks);
    uint4 x1 = *(const uint4*)(xr1 + 16 * ks);
#pragma unroll
    for (int d = 0; d < 2; ++d) {
      const float* wp = wj + d * 128 + 16 * ks + hi * 8;
      float4 wa = *(const float4*)wp, wb = *(const float4*)(wp + 4);
      bf16x8 a0 = mk8(pk2(bflo(x0.x) * wa.x, bfhi(x0.x) * wa.y), pk2(bflo(x0.y) * wa.z, bfhi(x0.y) * wa.w),
                      pk2(bflo(x0.z) * wb.x, bfhi(x0.z) * wb.y), pk2(bflo(x0.w) * wb.z, bfhi(x0.w) * wb.w));
      bf16x8 a1 = mk8(pk2(bflo(x1.x) * wa.x, bfhi(x1.x) * wa.y), pk2(bflo(x1.y) * wa.z, bfhi(x1.y) * wa.w),
                      pk2(bflo(x1.z) * wb.x, bfhi(x1.z) * wb.y), pk2(bflo(x1.w) * wb.z, bfhi(x1.w) * wb.w));
      acc[d][0] = mfma32(a0, bop, acc[d][0]);
      acc[d][1] = mfma32(a1, bop, acc[d][1]);
    }
  }
  float* ST = (float*)(P.ws + OFF_ST);
#pragma unroll
  for (int d = 0; d < 2; ++d)
#pragma unroll
    for (int mt = 0; mt < 2; ++mt)
#pragma unroll
      for (int i = 0; i < 16; ++i) {
        int p = mt * 32 + 8 * (i >> 2) + 4 * hi + (i & 3);
        ST[((size_t)(cgk * 2 + d) * 4 + h) * 8192 + p * 128 + w * 32 + q] = acc[d][mt][i];
      }
  half_barrier(hb);
}

DEVI void phase_ssd_scan(const Params& P) {
  const float* ST = (const float*)(P.ws + OFF_ST);
  const float* CD = (const float*)(P.ws + OFF_CD);
  bf16_t* HS = (bf16_t*)(P.ws + OFF_HS);
  const int tid = otid();
  for (int idx = vbid() * 256 + tid; idx < 2 * 2 * 4 * 8192; idx += nvb() * 256) {
    int e = idx & 8191, h = (idx >> 13) & 3, dir = (idx >> 15) & 1, b = idx >> 16;
    float state = 0.f;
#pragma unroll 22
    for (int step = 0; step < 66; ++step) {
      int c = dir == 0 ? step : (step == 0 ? 1 : (step == 1 ? 0 : 67 - step));
      int cgk = b * 66 + c;
      size_t off = ((size_t)(cgk * 2 + dir) * 4 + h) * 8192 + e;
      HS[off] = f2bf(state);
      state = state * CD[cgk * 8 + dir * 4 + h] + ST[off];
    }
  }
}

DEVI void ssd_s3_unit(const Params& P, int l, int cgk, int qb, float* smem) {
  const int tid = otid(), h = tid >> 6, lane = tid & 63, q = lane & 31, hi = lane >> 5;
  const int b = cgk / 66, c = cgk - b * 66;
  const int t0 = c * 128, r0 = cgk * 128;
  const int g = h >> 1;
  float4* tab = (float4*)smem;
  float* red = smem + 4 * 128 * 4;
  const float* DT = (const float*)(P.ws + OFF_DT);
  const float* LL = (const float*)(P.ws + OFF_L);
  for (int i = tid; i < 512; i += 256) {
    int hh = i >> 7, j = i & 127;
    size_t o = (size_t)(r0 + j) * 8;
    tab[i] = make_float4(LL[o + hh], LL[o + 4 + hh], DT[o + hh], DT[o + 4 + hh]);
  }
  __syncthreads();
  const int ti = qb * 32 + q;
  const bf16_t* XBC = (const bf16_t*)(P.ws + OFF_XBC);
  const bf16_t* crow = XBC + (size_t)(r0 + ti) * 768 + 512 + g * 128 + hi * 8;
  bf16x8 qop[8];
#pragma unroll
  for (int s = 0; s < 8; ++s) qop[s] = ld8(crow + 16 * s);
  const float4 me = tab[h * 128 + ti];
  const float Li0 = me.x, Li1 = me.y;
  f32x16 o0, o1;
#pragma unroll
  for (int i = 0; i < 16; ++i) { o0[i] = 0.f; o1[i] = 0.f; }
  const bf16_t* XT = (const bf16_t*)(P.ws + OFF_XBCT) + (size_t)b * 512 * TOK + t0;
#pragma unroll 1
  for (int jb = 0; jb < 4; ++jb) {
    f32x16 st;
#pragma unroll
    for (int i = 0; i < 16; ++i) st[i] = 0.f;
    const bf16_t* brow = XBC + (size_t)(r0 + jb * 32 + q) * 768 + 256 + g * 128 + hi * 8;
#pragma unroll
    for (int s = 0; s < 8; ++s) st = mfma32(ld8(brow + 16 * s), qop[s], st);
    float wv[16];
#pragma unroll
    for (int i = 0; i < 16; ++i) {
      int j = jb * 32 + 8 * (i >> 2) + 4 * hi + (i & 3);
      float4 tj = tab[h * 128 + j];
      float wgt = 0.f;
      if (j <= ti) wgt += tj.z * __expf(fminf(Li0 - tj.x, 0.f));
      if (j >= ti) wgt += tj.w * __expf(fminf(Li1 - tj.y, 0.f));
      wv[i] = st[i] * wgt;
    }
    bf16x8 p0 = mk8(pk2(wv[0], wv[1]), pk2(wv[2], wv[3]), pk2(wv[4], wv[5]), pk2(wv[6], wv[7]));
    bf16x8 p1 = mk8(pk2(wv[8], wv[9]), pk2(wv[10], wv[11]), pk2(wv[12], wv[13]), pk2(wv[14], wv[15]));
    const bf16_t* vp = XT + (size_t)(h * 64 + q) * TOK + jb * 32 + 4 * hi;
    const bf16_t* vp1 = vp + (size_t)32 * TOK;
    o0 = mfma32(ld4x2(vp, vp + 8), p0, o0);
    o0 = mfma32(ld4x2(vp + 16, vp + 24), p1, o0);
    o1 = mfma32(ld4x2(vp1, vp1 + 8), p0, o1);
    o1 = mfma32(ld4x2(vp1 + 16, vp1 + 24), p1, o1);
  }
  const bf16_t* HS = (const bf16_t*)(P.ws + OFF_HS);
#pragma unroll 1
  for (int d = 0; d < 2; ++d) {
    const bf16_t* hp = HS + ((size_t)(cgk * 2 + d) * 4 + h) * 8192 + (size_t)q * 128 + hi * 8;
    f32x16 a0, a1;
#pragma unroll
    for (int i = 0; i < 16; ++i) { a0[i] = 0.f; a1[i] = 0.f; }
#pragma unroll
    for (int s = 0; s < 8; ++s) {
      a0 = mfma32(ld8(hp + 16 * s), qop[s], a0);
      a1 = mfma32(ld8(hp + 32 * 128 + 16 * s), qop[s], a1);
    }
    float e = __expf(d == 0 ? Li0 : Li1);
#pragma unroll
    for (int i = 0; i < 16; ++i) { o0[i] += e * a0[i]; o1[i] += e * a1[i]; }
  }
  const float dsk = P.in[I_SSDD][l * 4 + h];
  const bf16_t* xrow = XBC + (size_t)(r0 + ti) * 768 + h * 64 + 4 * hi;
  const bf16_t* zrow = (const bf16_t*)(P.ws + OFF_P) + (size_t)(r0 + ti) * PP + C_SZ + h * 64 + 4 * hi;
  float ssq = 0.f;
#pragma unroll
  for (int i4 = 0; i4 < 4; ++i4) {
    uint2 xa = *(const uint2*)(xrow + 8 * i4), xb = *(const uint2*)(xrow + 32 + 8 * i4);
    uint2 za = *(const uint2*)(zrow + 8 * i4), zb = *(const uint2*)(zrow + 32 + 8 * i4);
    float xs0[4] = {bflo(xa.x), bfhi(xa.x), bflo(xa.y), bfhi(xa.y)};
    float xs1[4] = {bflo(xb.x), bfhi(xb.x), bflo(xb.y), bfhi(xb.y)};
    float zs0[4] = {bflo(za.x), bfhi(za.x), bflo(za.y), bfhi(za.y)};
    float zs1[4] = {bflo(zb.x), bfhi(zb.x), bflo(zb.y), bfhi(zb.y)};
#pragma unroll
    for (int k = 0; k < 4; ++k) {
      float y0 = (o0[4 * i4 + k] + dsk * xs0[k]) * siluf(zs0[k]);
      float y1 = (o1[4 * i4 + k] + dsk * xs1[k]) * siluf(zs1[k]);
      o0[4 * i4 + k] = y0; o1[4 * i4 + k] = y1;
      ssq += y0 * y0 + y1 * y1;
    }
  }
  ssq += __shfl_xor(ssq, 32);
  if (hi == 0) red[h * 32 + q] = ssq;
  __syncthreads();
  float tot = red[q] + red[32 + q] + red[64 + q] + red[96 + q];
  float rstd = rsqrtf(tot * (1.f / 256.f) + 1e-6f);
  const float* gn = P.in[I_SSDG] + l * 256 + h * 64 + 4 * hi;
  bf16_t* op = (bf16_t*)(P.ws + OFF_A) + (size_t)(r0 + ti) * DM + 768 + h * 64 + 4 * hi;
#pragma unroll
  for (int i4 = 0; i4 < 4; ++i4) {
    float4 ga = *(const float4*)(gn + 8 * i4), gb = *(const float4*)(gn + 32 + 8 * i4);
    *(uint2*)(op + 8 * i4) = make_uint2(pk2(o0[4 * i4] * rstd * ga.x, o0[4 * i4 + 1] * rstd * ga.y), pk2(o0[4 * i4 + 2] * rstd * ga.z, o0[4 * i4 + 3] * rstd * ga.w));
    *(uint2*)(op + 32 + 8 * i4) = make_uint2(pk2(o1[4 * i4] * rstd * gb.x, o1[4 * i4 + 1] * rstd * gb.y), pk2(o1[4 * i4 + 2] * rstd * gb.z, o1[4 * i4 + 3] * rstd * gb.w));
  }
  __syncthreads();
}

typedef __attribute__((address_space(3))) unsigned char lds_u8;
DEVI void phase_gemm_in(const Params& P, int l, lds_u8* lds) {
  pg8::Gemm g{(const bf16_t*)(P.ws + OFF_A), (const bf16_t*)(P.ws + OFF_WTIN) + (size_t)l * PP * 1024, MROWS, PP, 1024};
  pg8::MySched S; S.init(66, 11, (int)gridDim.x, (int)blockIdx.x, 0);
  pg8::EpiStore<0> E{(bf16_t*)(P.ws + OFF_P), PP};
  pg8::gemm_phase<pg8::EpiStore<0>, pg8::MySched, true, true>(lds, g, S, E);
}

DEVI void phase_mla_gemm(const Params& P, int l, bf16_t* smem) {
  const bf16_t* Pm = (const bf16_t*)(P.ws + OFF_P);
  const bf16_t* Wq = (const bf16_t*)(P.ws + OFF_WTUQ) + (size_t)l * 384 * 256;
  const bf16_t* Wkv = (const bf16_t*)(P.ws + OFF_WTUKV) + (size_t)l * 512 * 128;
  bf16_t* MQ = (bf16_t*)(P.ws + OFF_MQ);
  bf16_t* MK = (bf16_t*)(P.ws + OFF_MK);
  bf16_t* VT = (bf16_t*)(P.ws + OFF_VTMLA);
  for (int u = vbid(); u < 132 * 7; u += nvb()) {
    int tm, tn;
    if (u < 396) { tm = u / 3; tn = u - tm * 3; } else { int r = u - 396; tm = r >> 2; tn = 3 + (r & 3); }
    if (tn < 3) {
      gemm_tile<true>(Pm + C_MCQ, PP, Wq, 256, 256, tm * 128, tn * 128, smem, [&](int m, int n, f32x4 v) {
        *(uint2*)(MQ + (size_t)m * 384 + n) = make_uint2(pk2(v[0], v[1]), pk2(v[2], v[3]));
      });
    } else {
      int hh = tn - 3;
      gemm_tile<true>(Pm + C_MCKV, PP, Wkv, 128, 128, tm * 128, hh * 128, smem, [&](int m, int n, f32x4 v) {
        int cc = n - hh * 128;
        if (cc < 64) {
          *(uint2*)(MK + (size_t)m * 256 + hh * 64 + cc) = make_uint2(pk2(v[0], v[1]), pk2(v[2], v[3]));
        } else {
          int bb = m / TOK, t = m - bb * TOK;
          int tp = (t & ~15) | (8 * ((t >> 2) & 1) + 4 * ((t >> 3) & 1) + (t & 3));
          bf16_t* d = VT + (size_t)(bb * 256 + hh * 64 + cc - 64) * TOK + tp;
          d[0] = f2bf(v[0]); d[TOK] = f2bf(v[1]); d[2 * TOK] = f2bf(v[2]); d[3 * TOK] = f2bf(v[3]);
        }
      });
    }
  }
}

DEVI void phase_mix(const Params& P, int l, float* smem, lds_u32* hbcnt) {
  const int w = otid() >> 6;
  if (otid() == 0) *hbcnt = 0u;
  __syncthreads();
  HalfBar hb{hbcnt, 0u};
  const int vb = vbid(), half = vb & 1;
#pragma unroll 1
  for (int jj = 0; jj < 5; ++jj) {
    const int j = half ? (jj == 4 ? 0 : jj + 1) : jj;
    const int u = vb + j * nvb();
    if (u >= 2112) continue;
    const bool small = u >= 2048;
    if (small && l == NLAYER - 1 && u < 2096) continue;
    const int kind = small ? ((u - 2048) >> 4) : (u >> 9);
    const int r = small ? ((u - 2048) & 15) : (u & 511);
    if (kind == 0) {
      const int bh = (r >> 1) & 7, qi = ((r >> 4) << 1) | (r & 1);
      mla_block(P, l, bh >> 2, bh & 3, small ? 1 : 0, qi * 128, (unsigned char*)smem, hb);
    } else if (kind == 3) {
      const int cc = r >> 2;
      const int cgk = small ? ((cc >> 1) * 66 + (cc & 1)) : ((cc >> 6) * 66 + 2 + (cc & 63));
      ssd_s1_unit(P, l, cgk, r & 3, smem, hb);
    } else {
      const int rr = small ? r : ((((r >> 1) & 7) << 6) | ((r >> 4) << 1) | (r & 1));
      const int wu = rr * 4 + w;
      int b, h, qt;
      if (!small) { b = wu >> 10; h = (wu >> 8) & 3; qt = wu & 255; }
      else { b = wu >> 5; h = (wu >> 3) & 3; qt = wu & 7; }
      if (kind == 1) flash_unit<1>(P, l, b, h, small ? 1 : 0, qt * 32);
      else flash_unit<0>(P, l, b, h, small ? 1 : 0, qt * 32);
    }
  }
}

DEVI void phase_ssd_out(const Params& P, int l, float* smem) {
  for (int u = vbid(); u < (l == NLAYER - 1 ? 512 : 528); u += nvb()) {
    const int cl = u >> 2;
    const int cgk = cl < 128 ? ((cl >> 6) * 66 + 2 + (cl & 63)) : (((cl - 128) >> 1) * 66 + ((cl - 128) & 1));
    ssd_s3_unit(P, l, cgk, u & 3, smem);
  }
}

DEVI void phase_gemm_res(const Params& P, int l, const bf16_t* A, int K, const bf16_t* Bt, int gate, lds_u8* lds, bf16_t* smem, const float* rdlat) {
  {
    pg8::Gemm g{A, Bt, MROWS, 1024, K};
    pg8::MySched S; S.init(64, 4, (int)gridDim.x, (int)blockIdx.x, 1);
    pg8::EpiRes E{P.out, (float*)(P.ws + OFF_HC), (const float*)(P.ws + OFF_MOD) + (size_t)l * 3 * 6144 + gate * 1024, rdlat};
    pg8::gemm_phase<pg8::EpiRes, pg8::MySched, false, true>(lds, g, S, E);
  }
  if (l == NLAYER - 1) return;
  const int kspl = K / 8;
  float* PART = (float*)(P.ws + OFF_PART);
  for (int u = vbid(); u < 256; u += nvb()) {
    int ks = u & 7, tile = u >> 3;
    int tn = tile & 7, ti = tile >> 3;
    int tm = (ti >> 1) * 66 + (ti & 1);
    gemm_tile(A + ks * kspl, K, Bt + ks * kspl, K, kspl, tm * 128, tn * 128, smem, [&](int m, int n, f32x4 v) {
      int bb = m / TOK, t = m - bb * TOK;
      const float* gp = modvec(P, l, 2, gate) + n;
      float4 gv = *(const float4*)gp;
      *(float4*)(PART + ((size_t)ks * 512 + bb * 256 + t) * 1024 + n) = make_float4(gv.x * v[0], gv.y * v[1], gv.z * v[2], gv.w * v[3]);
    });
  }
}

DEVI void phase_mlp1(const Params& P, int l, lds_u8* lds, bf16_t* smem) {
  const bf16_t* A = (const bf16_t*)(P.ws + OFF_A);
  const bf16_t* Bt = (const bf16_t*)(P.ws + OFF_WT1) + (size_t)l * 4096 * 1024;
  bf16_t* H = (bf16_t*)(P.ws + OFF_HID);
  {
    pg8::Gemm g{A, Bt, MROWS, 4096, 1024};
    pg8::MySched S; S.init(64, 16, (int)gridDim.x, (int)blockIdx.x, 1);
    pg8::EpiStore<1> E{H, DFF};
    pg8::gemm_phase<pg8::EpiStore<1>, pg8::MySched, true, true>(lds, g, S, E);
  }
  if (l == NLAYER - 1) return;
  for (int u = vbid(); u < 4 * 32; u += nvb()) {
    int ti = u >> 5, tn = u & 31;
    int tm = (ti >> 1) * 66 + (ti & 1);
    gemm_tile(A, DM, Bt, 1024, 1024, tm * 128, tn * 128, smem, [&](int m, int n, f32x4 v) {
      float a0 = fmaxf(v[0], 0.f), a1 = fmaxf(v[1], 0.f), a2 = fmaxf(v[2], 0.f), a3 = fmaxf(v[3], 0.f);
      *(uint2*)(H + (size_t)m * DFF + n) = make_uint2(pk2(a0 * a0, a1 * a1), pk2(a2 * a2, a3 * a3));
    });
  }
}

constexpr int NPH = 1 + 10 * NLAYER + 1;

constexpr int LDS_HALF = 73728, LDS_BYTES = 2 * LDS_HALF + 64;
__global__ void __launch_bounds__(512, 2) mega(Params P) {
  extern __shared__ __attribute__((aligned(16))) unsigned char lds[];
  lds_u8* ldsg = (lds_u8*)lds;
  volatile unsigned* xbst = (volatile unsigned*)(lds + 2 * LDS_HALF);
  unsigned* bar = (unsigned*)(P.ws + OFF_BAR);
  const unsigned xcc = xb_xcc_id();
  if (threadIdx.x == 0) { xbst[0] = 0u; xbst[1] = 0u; (void)xb_add(&bar[XB_XCNT(xcc)], 1u); }
  __syncthreads();
  for (int ph = P.ph_lo; ph < P.ph_hi; ++ph) {
    Params Q = P;
    { unsigned long long w_ = (unsigned long long)Q.ws, o_ = (unsigned long long)P.out; asm volatile("" : "+s"(w_), "+s"(o_)); Q.ws = (unsigned char*)w_; Q.out = (float*)o_; }
    unsigned char* smem = lds + (rtid() >> 8) * LDS_HALF;
    if (ph == 0) phase_prologue(Q, smem);
    else if (ph == NPH - 1) phase_final(Q);
    else {
      int ph2 = ph; asm volatile("" : "+s"(ph2));
      int l = (ph2 - 1) / 10, s = (ph2 - 1) % 10;
      switch (s) {
        case 0: phase_norm(Q, l, Q.in[I_G1] + l * DM, 0, l > 0, l == 0 ? Q.in[I_X] : Q.out); break;
        case 1: phase_gemm_in(Q, l, ldsg); break;
        case 2: phase_prep(Q, l, smem); phase_mla_gemm(Q, l, (bf16_t*)smem); break;
        case 3: phase_mix(Q, l, (float*)smem, (lds_u32*)(ldsg + (rtid() >> 8) * LDS_HALF + LDS_HALF - 16)); break;
        case 4: phase_ssd_scan(Q); break;
        case 5: phase_ssd_out(Q, l, (float*)smem); break;
        case 6: phase_gemm_res(Q, l, (const bf16_t*)(Q.ws + OFF_A), 1024, (const bf16_t*)(Q.ws + OFF_WTOUT) + (size_t)l * 1024 * 1024, 2, ldsg, (bf16_t*)smem, l == 0 ? Q.in[I_X] : Q.out); break;
        case 7: phase_norm(Q, l, Q.in[I_G2] + l * DM, 3, l < NLAYER - 1, Q.out); break;
        case 8: phase_mlp1(Q, l, ldsg, (bf16_t*)smem); break;
        case 9: phase_gemm_res(Q, l, (const bf16_t*)(Q.ws + OFF_HID), 4096, (const bf16_t*)(Q.ws + OFF_WT2) + (size_t)l * 1024 * 4096, 5, ldsg, (bf16_t*)smem, Q.out); break;
      }
    }
    if (ph + 1 < P.ph_hi) {
      if (P.use_cg) cg::this_grid().sync();
      else xcd_barrier(bar, xcc, xbst);
    }
  }
}

extern "C" void kernel_launch(void* const* d_in, const int* in_sizes, int n_in, void* d_out, int out_size, void* d_ws, size_t ws_size,
                              hipStream_t stream) {
  static int grid_blocks = 0;
  if (!grid_blocks) {
    int dev = 0, cus = 0, per_cu = 0;
    (void)hipGetDevice(&dev);
    (void)hipDeviceGetAttribute(&cus, hipDeviceAttributeMultiprocessorCount, dev);
    if (hipFuncSetAttribute((const void*)mega, hipFuncAttributeMaxDynamicSharedMemorySize, LDS_BYTES) != hipSuccess)
      fprintf(stderr, "hipFuncSetAttribute(MaxDynamicSharedMemorySize) failed\n");
    (void)hipOccupancyMaxActiveBlocksPerMultiprocessor(&per_cu, (const void*)mega, 512, LDS_BYTES);
    if (per_cu < 1) fprintf(stderr, "occupancy query reports %d blocks per CU\n", per_cu);
    (void)hipGetLastError();
    grid_blocks = cus;
  }
  if (ws_size < WS_END) { fprintf(stderr, "workspace too small: %zu < %zu\n", ws_size, (size_t)WS_END); return; }
  Params p{};
  for (int i = 0; i < 25; ++i) p.in[i] = (const float*)d_in[i];
  p.out = (float*)d_out;
  p.ws = (unsigned char*)d_ws;
  p.ph_lo = 0; p.ph_hi = NPH; p.use_cg = 0; p.pad = 0;
  (void)hipMemsetAsync((unsigned char*)d_ws + OFF_BAR, 0, 16384, stream);
  void* args[] = {&p};
  hipError_t e = hipLaunchCooperativeKernel((void*)mega, dim3(grid_blocks), dim3(512), args, LDS_BYTES, stream);
  if (e != hipSuccess) fprintf(stderr, "cooperative launch failed: %s (grid %d)\n", hipGetErrorString(e), grid_blocks);
}
```
